# Optimizing an MI355X kernel written in HIP

```python
import jax, jax.numpy as jnp
from jax import lax
import numpy as np

D_MODEL = 1024
BATCH = 8
SEQ = 8192
DEPTH = 1

CHUNK = 64

MIX_WIDTH = D_MODEL
CONV_W = MIX_WIDTH // 2
LRU_W = MIX_WIDTH - CONV_W
N_CONV_HEADS = 8
N_LRU_HEADS = 8
CONV_HD = CONV_W // N_CONV_HEADS
LRU_HD = LRU_W // N_LRU_HEADS
SHORT_CONV_K = 3
LRU_CONV_K = 4
LRU_C = 8.0
N_IN = 3 * CONV_W + 2 * LRU_W

PEER_HEADS = 8
PEER_TOPK = 16
N_KEYS = 128
N_EXPERTS = N_KEYS * N_KEYS
PEER_DK = 128
PEER_DK_HALF = PEER_DK // 2
PEER_BLOCK = 128

EPS = 1e-6

kernel_name = "hybrid_conv_rglru_peer_adaln_block"


def rmsnorm(x, g):
    x32 = x.astype(jnp.float32)
    y = x32 * lax.rsqrt(jnp.mean(x32 * x32, axis=-1, keepdims=True) + EPS)
    return y.astype(x.dtype) * g


def head_rmsnorm(y, g, n_heads):
    b, s, w = y.shape
    yh = y.reshape(b, s, n_heads, w // n_heads).astype(jnp.float32)
    yh = yh * lax.rsqrt(jnp.mean(yh * yh, axis=-1, keepdims=True) + EPS)
    return yh.reshape(b, s, w).astype(y.dtype) * g


def modulate(h, shift, scale):
    return h * (1.0 + scale[:, None, :]) + shift[:, None, :]


def causal_dwconv(x, w):
    k_w = w.shape[0]
    s = x.shape[1]
    xp = jnp.pad(x, ((0, 0), (k_w - 1, 0), (0, 0)))
    out = xp[:, 0:s] * w[0]
    for k in range(1, k_w):
        out = out + xp[:, k:k + s] * w[k]
    return out


def rg_lru(xr, w_r, b_r, w_i, b_i, lam):
    b, s, _ = xr.shape
    xh = xr.reshape(b, s, N_LRU_HEADS, LRU_HD)
    r = jax.nn.sigmoid(jnp.einsum('bshi,hij->bshj', xh, w_r) + b_r).astype(jnp.float32)
    i = jax.nn.sigmoid(jnp.einsum('bshi,hij->bshj', xh, w_i) + b_i).astype(jnp.float32)
    log_a = -LRU_C * r * jax.nn.softplus(-lam.astype(jnp.float32))
    a = jnp.exp(log_a)
    u = jnp.sqrt(-jnp.expm1(2.0 * log_a)) * (i * xh.astype(jnp.float32))

    def combine(e1, e2):
        a1, b1 = e1
        a2, b2 = e2
        return a1 * a2, a2 * b1 + b2

    _, h = lax.associative_scan(combine, (a, u), axis=1)
    return h.reshape(b, s, LRU_W).astype(xr.dtype)


def peer(h, w_q, sub_keys, expert_u, expert_v):
    b, s, d = h.shape
    t = b * s
    hb = h.reshape(t // PEER_BLOCK, PEER_BLOCK, d)
    kk = PEER_TOPK * PEER_TOPK

    def block(xb):
        p = xb.shape[0]
        q = (xb @ w_q).reshape(p, PEER_HEADS, 2, PEER_DK_HALF)
        sc = jnp.einsum('phcd,hcnd->phcn', q, sub_keys).astype(jnp.float32)
        top_s, top_i = lax.top_k(sc, PEER_TOPK)
        cand_s = (top_s[:, :, 0, :, None] + top_s[:, :, 1, None, :]).reshape(p, PEER_HEADS, kk)
        cand_i = (top_i[:, :, 0, :, None] * N_KEYS + top_i[:, :, 1, None, :]).reshape(p, PEER_HEADS, kk)
        best_s, best_pos = lax.top_k(cand_s, PEER_TOPK)
        idx = jnp.take_along_axis(cand_i, best_pos, axis=-1)
        g = jax.nn.softmax(best_s, axis=-1)
        u_sel = expert_u[idx]
        act = jax.nn.gelu(jnp.einsum('phkd,pd->phk', u_sel, xb), approximate=False)
        coef = (g * act.astype(jnp.float32)).astype(xb.dtype)
        return jnp.einsum('phk,phkd->pd', coef, expert_v[idx])

    return lax.map(block, hb).reshape(b, s, d)


def setup_inputs(seed: int = 0) -> dict:
    key = jax.random.key(seed)
    ks = jax.random.split(key, 24)
    f32 = jnp.float32
    L = DEPTH

    def nrm(k, shape, scale):
        return jax.random.normal(k, shape, f32) * scale

    a8 = jax.random.uniform(ks[13], (L, N_LRU_HEADS, LRU_HD), f32, 0.9, 0.999)
    a_base = a8 ** (1.0 / LRU_C)
    lru_lambda = jnp.log(a_base) - jnp.log1p(-a_base)

    return {
        "x": nrm(ks[0], (BATCH, SEQ, D_MODEL), 1.0),
        "c": nrm(ks[1], (BATCH, D_MODEL), 1.0),
        "w_ada": nrm(ks[2], (L, D_MODEL, 6 * D_MODEL), 0.5 * D_MODEL ** -0.5),
        "b_ada": nrm(ks[3], (L, 6 * D_MODEL), 0.02),
        "norm1_g": 1.0 + nrm(ks[4], (L, D_MODEL), 0.02),
        "w_in": nrm(ks[5], (L, D_MODEL, N_IN), D_MODEL ** -0.5),
        "conv_a_w": nrm(ks[6], (L, SHORT_CONV_K, CONV_W), SHORT_CONV_K ** -0.5),
        "conv_b_w": nrm(ks[7], (L, LRU_CONV_K, LRU_W), LRU_CONV_K ** -0.5),
        "conv_b_b": nrm(ks[8], (L, LRU_W), 0.02),
        "w_r": nrm(ks[9], (L, N_LRU_HEADS, LRU_HD, LRU_HD), LRU_HD ** -0.5),
        "b_r": nrm(ks[10], (L, N_LRU_HEADS, LRU_HD), 0.02),
        "w_i": nrm(ks[11], (L, N_LRU_HEADS, LRU_HD, LRU_HD), LRU_HD ** -0.5),
        "b_i": nrm(ks[12], (L, N_LRU_HEADS, LRU_HD), 0.02),
        "lru_lambda": lru_lambda,
        "gn_a": 1.0 + nrm(ks[14], (L, CONV_W), 0.02),
        "gn_b": 1.0 + nrm(ks[15], (L, LRU_W), 0.02),
        "w_out": nrm(ks[16], (L, MIX_WIDTH, D_MODEL), MIX_WIDTH ** -0.5),
        "norm2_g": 1.0 + nrm(ks[17], (L, D_MODEL), 0.02),
        "w_q": nrm(ks[18], (L, D_MODEL, PEER_HEADS * PEER_DK), D_MODEL ** -0.5),
        "sub_keys": nrm(ks[19], (L, PEER_HEADS, 2, N_KEYS, PEER_DK_HALF), PEER_DK_HALF ** -0.5),
        "expert_u": nrm(ks[20], (L, N_EXPERTS, D_MODEL), D_MODEL ** -0.5),
        "expert_v": nrm(ks[21], (L, N_EXPERTS, D_MODEL), PEER_HEADS ** -0.5),
        "final_g": 1.0 + nrm(ks[22], (D_MODEL,), 0.02),
    }


def reference(x, c, w_ada, b_ada, norm1_g, w_in, conv_a_w, conv_b_w, conv_b_b,
              w_r, b_r, w_i, b_i, lru_lambda, gn_a, gn_b, w_out,
              norm2_g, w_q, sub_keys, expert_u, expert_v, final_g):
    c_act = jax.nn.silu(c)
    for l in range(DEPTH):
        ada = c_act @ w_ada[l] + b_ada[l]
        sh1, sc1, g1, sh2, sc2, g2 = jnp.split(ada, 6, axis=-1)

        h = modulate(rmsnorm(x, norm1_g[l]), sh1, sc1)
        z = h @ w_in[l]
        gate_b, gate_c, xa, xr, gr = jnp.split(
            z, [CONV_W, 2 * CONV_W, 3 * CONV_W, 3 * CONV_W + LRU_W], axis=-1)

        y_a = gate_b * causal_dwconv(gate_c * xa, conv_a_w[l])

        xr = causal_dwconv(xr, conv_b_w[l]) + conv_b_b[l]
        y_b = rg_lru(xr, w_r[l], b_r[l], w_i[l], b_i[l], lru_lambda[l]) * jax.nn.gelu(gr)

        y = jnp.concatenate([head_rmsnorm(y_a, gn_a[l], N_CONV_HEADS),
                             head_rmsnorm(y_b, gn_b[l], N_LRU_HEADS)], axis=-1) @ w_out[l]
        x = x + g1[:, None, :] * y

        h = modulate(rmsnorm(x, norm2_g[l]), sh2, sc2)
        x = x + g2[:, None, :] * peer(h, w_q[l], sub_keys[l], expert_u[l], expert_v[l])

    return rmsnorm(x, final_g)
```

```cpp
#include <hip/hip_runtime.h>
#include <hip/hip_cooperative_groups.h>
#include <cstdio>
namespace cg = cooperative_groups;

#ifndef MULTI_LAUNCH
#define MULTI_LAUNCH 1
#endif

typedef unsigned short u16;
using bf16x8 = __attribute__((ext_vector_type(8))) short;
using f32x16 = __attribute__((ext_vector_type(16))) float;

#define DEV __device__ __forceinline__

constexpr int NT = 512;
constexpr int T_ = 65536;
constexpr int LDS_BYTES = 73728;
constexpr int LROW = 144;
constexpr int STAGE = 256 * LROW;

struct Params {
  const float *x, *c, *w_ada, *b_ada, *norm1_g, *w_in, *conv_a_w, *conv_b_w, *conv_b_b;
  const float *w_r, *b_r, *w_i, *b_i, *lam, *gn_a, *gn_b, *w_out, *norm2_g, *w_q, *sub_keys;
  const float *expert_u, *expert_v, *final_g;
  float* out;
  float* ada;
  u16 *WinT, *WoutT, *WqT;
  u16 *keysF, *WrF, *WiF;
  u16 *Ub, *Vb;
  u16 *h;
  u16 *z;
  u16 *ycat;
  u16 *hloc, *logP;
  float *Hend, *Pend;
  float *x1;
  int* idx;
  float* gsel;
};

DEV u16 f2bf(float f) {
  unsigned u = __float_as_uint(f);
  u += 0x7FFFu + ((u >> 16) & 1u);
  return (u16)(u >> 16);
}
DEV float bf2f(u16 h) { return __uint_as_float(((unsigned)h) << 16); }
DEV unsigned pack2(float a, float b) { return (unsigned)f2bf(a) | ((unsigned)f2bf(b) << 16); }
DEV void unpack8(uint4 v, float* f) {
  f[0] = __uint_as_float(v.x << 16); f[1] = __uint_as_float(v.x & 0xFFFF0000u);
  f[2] = __uint_as_float(v.y << 16); f[3] = __uint_as_float(v.y & 0xFFFF0000u);
  f[4] = __uint_as_float(v.z << 16); f[5] = __uint_as_float(v.z & 0xFFFF0000u);
  f[6] = __uint_as_float(v.w << 16); f[7] = __uint_as_float(v.w & 0xFFFF0000u);
}
DEV float sigm(float x) { return 1.f / (1.f + __expf(-x)); }
DEV float gelu_tanh(float x) {
  float u = 0.7978845608028654f * (x + 0.044715f * x * x * x);
  float t = 1.f - 2.f / (1.f + __expf(2.f * u));
  return 0.5f * x * (1.f + t);
}
DEV float wave_allsum(float v) {
#pragma unroll
  for (int o = 32; o > 0; o >>= 1) v += __shfl_xor(v, o, 64);
  return v;
}
template <int CTRL> DEV unsigned dpp_u(unsigned v) {
  return (unsigned)__builtin_amdgcn_update_dpp((int)v, (int)v, CTRL, 0xF, 0xF, true);
}
DEV unsigned row_max_u(unsigned v) {
  v = max(v, dpp_u<0xB1>(v));
  v = max(v, dpp_u<0x4E>(v));
  v = max(v, dpp_u<0x141>(v));
  v = max(v, dpp_u<0x140>(v));
  return v;
}
DEV float row_sum_f(float v) {
  v += __uint_as_float(dpp_u<0xB1>(__float_as_uint(v)));
  v += __uint_as_float(dpp_u<0x4E>(__float_as_uint(v)));
  v += __uint_as_float(dpp_u<0x141>(__float_as_uint(v)));
  v += __uint_as_float(dpp_u<0x140>(__float_as_uint(v)));
  return v;
}
DEV unsigned sortable(float f) {
  unsigned k = __float_as_uint(f);
  return (k & 0x80000000u) ? ~k : (k | 0x80000000u);
}
DEV float unsortable(unsigned k) {
  return __uint_as_float((k & 0x80000000u) ? (k & 0x7FFFFFFFu) : ~k);
}
DEV f32x16 mfma32(bf16x8 a, bf16x8 b, f32x16 c) {
  return __builtin_amdgcn_mfma_f32_32x32x16_bf16(a, b, c, 0, 0, 0);
}
DEV int crow(int reg, int lane) { return (reg & 3) + 8 * (reg >> 2) + 4 * (lane >> 5); }

DEV void p0_ada(const Params& p, int item, char* smem) {
  float* sRed = (float*)smem;
  const int tid = threadIdx.x, w = tid >> 6, lane = tid & 63;
  const int col = item * 128 + lane * 2;
  float acc[8][2];
#pragma unroll
  for (int b = 0; b < 8; ++b) { acc[b][0] = 0.f; acc[b][1] = 0.f; }
#pragma unroll 8
  for (int kk = 0; kk < 128; ++kk) {
    const int k = w * 128 + kk;
    const float2 wv = *(const float2*)(p.w_ada + (size_t)k * 6144 + col);
#pragma unroll
    for (int b = 0; b < 8; ++b) {
      const float cv = p.c[b * 1024 + k];
      const float s = cv / (1.f + __expf(-cv));
      acc[b][0] += s * wv.x; acc[b][1] += s * wv.y;
    }
  }
#pragma unroll
  for (int b = 0; b < 8; ++b) {
    sRed[(w * 8 + b) * 128 + lane * 2 + 0] = acc[b][0];
    sRed[(w * 8 + b) * 128 + lane * 2 + 1] = acc[b][1];
  }
  __syncthreads();
  for (int o = tid; o < 1024; o += NT) {
    const int b = o >> 7, cl = o & 127;
    float s = 0.f;
#pragma unroll
    for (int w2 = 0; w2 < 8; ++w2) s += sRed[(w2 * 8 + b) * 128 + cl];
    p.ada[b * 6144 + item * 128 + cl] = s + p.b_ada[item * 128 + cl];
  }
  __syncthreads();
}

DEV void p0_transpose(const float* W, int K, int N, u16* Wt, int item, char* smem) {
  float* sT = (float*)smem;
  const int ntn = N >> 6;
  const int nt = item % ntn, kt = item / ntn;
  const int tid = threadIdx.x;
#pragma unroll
  for (int i = 0; i < 8; ++i) {
    const int e = tid + i * NT, r = e >> 6, c = e & 63;
    sT[r * 65 + c] = W[(size_t)(kt * 64 + r) * N + nt * 64 + c];
  }
  __syncthreads();
#pragma unroll
  for (int i = 0; i < 8; ++i) {
    const int e = tid + i * NT, r = e >> 6, c = e & 63;
    Wt[(size_t)(nt * 64 + r) * K + kt * 64 + c] = f2bf(sT[c * 65 + r]);
  }
  __syncthreads();
}

DEV void p0_keys(const Params& p, int item) {
#pragma unroll
  for (int i = 0; i < 8; ++i) {
    const int o = item * 4096 + i * NT + threadIdx.x;
    const int j = o & 7, lane = (o >> 3) & 63, kk = (o >> 9) & 3, nt = (o >> 11) & 3, hc = o >> 13;
    const int n = nt * 32 + (lane & 31), k = kk * 16 + (lane >> 5) * 8 + j;
    p.keysF[o] = f2bf(p.sub_keys[(hc * 128 + n) * 64 + k]);
  }
}
DEV void p0_gate(const float* W, u16* WF, int item) {
#pragma unroll
  for (int i = 0; i < 8; ++i) {
    const int o = item * 4096 + i * NT + threadIdx.x;
    const int j = o & 7, lane = (o >> 3) & 63, kk = (o >> 9) & 3, nt = (o >> 11) & 1, hh = o >> 12;
    const int n = nt * 32 + (lane & 31), k = kk * 16 + (lane >> 5) * 8 + j;
    WF[o] = f2bf(W[(hh * 64 + k) * 64 + n]);
  }
}
DEV void p0_expert(const float* src, u16* dst, int item) {
  const size_t e0 = (size_t)item * 4096 + (size_t)threadIdx.x * 8;
  const float4 a = *(const float4*)(src + e0), b = *(const float4*)(src + e0 + 4);
  uint4 o;
  o.x = pack2(a.x, a.y); o.y = pack2(a.z, a.w); o.z = pack2(b.x, b.y); o.w = pack2(b.z, b.w);
  *(uint4*)(dst + e0) = o;
}
constexpr int P0_ITEMS = 48 + 640 + 256 + 256 + 32 + 8 + 8 + 4096 + 4096;
DEV void phase0(const Params& p, int item, char* smem) {
  if (item < 48) { p0_ada(p, item, smem); return; }
  item -= 48;
  if (item < 640) { p0_transpose(p.w_in, 1024, 2560, p.WinT, item, smem); return; }
  item -= 640;
  if (item < 256) { p0_transpose(p.w_out, 1024, 1024, p.WoutT, item, smem); return; }
  item -= 256;
  if (item < 256) { p0_transpose(p.w_q, 1024, 1024, p.WqT, item, smem); return; }
  item -= 256;
  if (item < 32) { p0_keys(p, item); return; }
  item -= 32;
  if (item < 8) { p0_gate(p.w_r, p.WrF, item); return; }
  item -= 8;
  if (item < 8) { p0_gate(p.w_i, p.WiF, item); return; }
  item -= 8;
  if (item < 4096) { p0_expert(p.expert_u, p.Ub, item); return; }
  item -= 4096;
  p0_expert(p.expert_v, p.Vb, item);
}

DEV void p_norm_mod(const float* xin, const float* g, const float* ada, int sh_off, int sc_off,
                    u16* hout, int item) {
  const int tid = threadIdx.x, lane = tid & 63, w = tid >> 6;
  const int t0 = item * 64 + w * 8;
  const int b = t0 >> 13;
  float4 gg[4], sc[4], sh[4];
#pragma unroll
  for (int i = 0; i < 4; ++i) {
    gg[i] = *(const float4*)(g + i * 256 + lane * 4);
    sc[i] = *(const float4*)(ada + b * 6144 + sc_off + i * 256 + lane * 4);
    sh[i] = *(const float4*)(ada + b * 6144 + sh_off + i * 256 + lane * 4);
    gg[i].x *= (1.f + sc[i].x); gg[i].y *= (1.f + sc[i].y); gg[i].z *= (1.f + sc[i].z); gg[i].w *= (1.f + sc[i].w);
  }
#pragma unroll 2
  for (int tt = 0; tt < 8; ++tt) {
    const size_t t = t0 + tt;
    float4 xv[4];
    float ss = 0.f;
#pragma unroll
    for (int i = 0; i < 4; ++i) {
      xv[i] = *(const float4*)(xin + t * 1024 + i * 256 + lane * 4);
      ss += xv[i].x * xv[i].x + xv[i].y * xv[i].y + xv[i].z * xv[i].z + xv[i].w * xv[i].w;
    }
    ss = wave_allsum(ss);
    const float rstd = rsqrtf(ss * (1.f / 1024.f) + 1e-6f);
#pragma unroll
    for (int i = 0; i < 4; ++i) {
      uint2 o;
      o.x = pack2(xv[i].x * rstd * gg[i].x + sh[i].x, xv[i].y * rstd * gg[i].y + sh[i].y);
      o.y = pack2(xv[i].z * rstd * gg[i].z + sh[i].z, xv[i].w * rstd * gg[i].w + sh[i].w);
      *(uint2*)(hout + t * 1024 + i * 256 + lane * 4) = o;
    }
  }
}

DEV void gemm_core(const u16* __restrict__ A, const u16* __restrict__ Bt, int m0, int n0, char* smem,
                   f32x16& acc0, f32x16& acc1) {
  const int tid = threadIdx.x, lane = tid & 63, w = tid >> 6, wr = w >> 1, wc = w & 1;
  const int lrow = tid >> 3, lc = tid & 7;
  const u16* ga = A + (size_t)(m0 + lrow) * 1024 + lc * 8;
  const u16* gb = Bt + (size_t)(n0 + lrow) * 1024 + lc * 8;
  const int lw = lrow * LROW + lc * 16;
  uint4 ra0 = *(const uint4*)ga, ra1 = *(const uint4*)(ga + 64 * 1024);
  uint4 rb0 = *(const uint4*)gb, rb1 = *(const uint4*)(gb + 64 * 1024);
  *(uint4*)(smem + lw) = ra0;
  *(uint4*)(smem + lw + 64 * LROW) = ra1;
  *(uint4*)(smem + lw + 128 * LROW) = rb0;
  *(uint4*)(smem + lw + 192 * LROW) = rb1;
  __syncthreads();
  const int a_off = (wr * 32 + (lane & 31)) * LROW + (lane >> 5) * 16;
  const int b_off = (128 + wc * 64 + (lane & 31)) * LROW + (lane >> 5) * 16;
#pragma unroll 1
  for (int kt = 0; kt < 16; ++kt) {
    char* cur = smem + (kt & 1) * STAGE;
    if (kt < 15) {
      const int ko = (kt + 1) * 64;
      ra0 = *(const uint4*)(ga + ko); ra1 = *(const uint4*)(ga + 64 * 1024 + ko);
      rb0 = *(const uint4*)(gb + ko); rb1 = *(const uint4*)(gb + 64 * 1024 + ko);
    }
#pragma unroll
    for (int kk = 0; kk < 4; ++kk) {
      const bf16x8 a = *(const bf16x8*)(cur + a_off + kk * 32);
      const bf16x8 b0 = *(const bf16x8*)(cur + b_off + kk * 32);
      const bf16x8 b1 = *(const bf16x8*)(cur + b_off + 32 * LROW + kk * 32);
      acc0 = mfma32(a, b0, acc0);
      acc1 = mfma32(a, b1, acc1);
    }
    if (kt < 15) {
      char* nxt = smem + ((kt + 1) & 1) * STAGE;
      *(uint4*)(nxt + lw) = ra0;
      *(uint4*)(nxt + lw + 64 * LROW) = ra1;
      *(uint4*)(nxt + lw + 128 * LROW) = rb0;
      *(uint4*)(nxt + lw + 192 * LROW) = rb1;
    }
    __syncthreads();
  }
}
DEV f32x16 zero16() {
  f32x16 z;
#pragma unroll
  for (int i = 0; i < 16; ++i) z[i] = 0.f;
  return z;
}

DEV void p2_gemm1(const Params& p, int item, char* smem) {
  const int mt = item / 20, nt = item % 20;
  f32x16 acc0 = zero16(), acc1 = zero16();
  gemm_core(p.h, p.WinT, mt * 128, nt * 128, smem, acc0, acc1);
  const int lane = threadIdx.x & 63, w = threadIdx.x >> 6;
  const int rb = mt * 128 + (w >> 1) * 32, cb = nt * 128 + (w & 1) * 64 + (lane & 31);
#pragma unroll
  for (int r = 0; r < 16; ++r) {
    const size_t row = rb + crow(r, lane);
    p.z[row * 2560 + cb] = f2bf(acc0[r]);
    p.z[row * 2560 + cb + 32] = f2bf(acc1[r]);
  }
}
DEV void p5_gemm2(const Params& p, int item, char* smem) {
  const int mt = item >> 3, nt = item & 7;
  f32x16 acc0 = zero16(), acc1 = zero16();
  gemm_core(p.ycat, p.WoutT, mt * 128, nt * 128, smem, acc0, acc1);
  const int lane = threadIdx.x & 63, w = threadIdx.x >> 6;
  const int rb = mt * 128 + (w >> 1) * 32, cb = nt * 128 + (w & 1) * 64 + (lane & 31);
  const int b = (mt * 128) >> 13;
  const float g1a = p.ada[b * 6144 + 2048 + cb], g1b = p.ada[b * 6144 + 2048 + cb + 32];
#pragma unroll
  for (int r = 0; r < 16; ++r) {
    const size_t row = rb + crow(r, lane);
    p.x1[row * 1024 + cb] = p.x[row * 1024 + cb] + g1a * acc0[r];
    p.x1[row * 1024 + cb + 32] = p.x[row * 1024 + cb + 32] + g1b * acc1[r];
  }
}

DEV void p3_mixer1(const Params& p, int item, char* smem) {
  const int tid = threadIdx.x, lane = tid & 63, w = tid >> 6;
  const int tile = item >> 3, h = item & 7;
  const int t0 = tile * 128;
  const int tb = t0 & 8191;
  float* sXr = (float*)smem;
  float* sCx = (float*)(smem + 131 * 68 * 4);
  for (int q = tid; q < 131 * 8; q += NT) {
    const int r = q >> 3, c8 = q & 7;
    float f[8];
    if (tb + r - 3 >= 0) {
      const uint4 v = *(const uint4*)(p.z + (size_t)(t0 + r - 3) * 2560 + 1536 + h * 64 + c8 * 8);
      unpack8(v, f);
    } else {
#pragma unroll
      for (int j = 0; j < 8; ++j) f[j] = 0.f;
    }
    *(float4*)(sXr + r * 68 + c8 * 8) = make_float4(f[0], f[1], f[2], f[3]);
    *(float4*)(sXr + r * 68 + c8 * 8 + 4) = make_float4(f[4], f[5], f[6], f[7]);
  }
  for (int q = tid; q < 130 * 8; q += NT) {
    const int r = q >> 3, c8 = q & 7;
    float f[8], g[8];
    if (tb + r - 2 >= 0) {
      const u16* zr = p.z + (size_t)(t0 + r - 2) * 2560 + h * 64 + c8 * 8;
      const uint4 v = *(const uint4*)(zr + 512);
      const uint4 v2 = *(const uint4*)(zr + 1024);
      unpack8(v, f); unpack8(v2, g);
#pragma unroll
      for (int j = 0; j < 8; ++j) f[j] *= g[j];
    } else {
#pragma unroll
      for (int j = 0; j < 8; ++j) f[j] = 0.f;
    }
    *(float4*)(sCx + r * 68 + c8 * 8) = make_float4(f[0], f[1], f[2], f[3]);
    *(float4*)(sCx + r * 68 + c8 * 8 + 4) = make_float4(f[4], f[5], f[6], f[7]);
  }
  __syncthreads();
  const int tl = tid >> 2, q4 = tid & 3;
  const size_t t = (size_t)t0 + tl;
  const int cb = h * 64 + q4 * 16;
  {
    float gb[16], ya[16];
    unpack8(*(const uint4*)(p.z + t * 2560 + cb), gb);
    unpack8(*(const uint4*)(p.z + t * 2560 + cb + 8), gb + 8);
    float ss = 0.f;
#pragma unroll
    for (int c4 = 0; c4 < 4; ++c4) {
      const float4 w0 = *(const float4*)(p.conv_a_w + cb + c4 * 4);
      const float4 w1 = *(const float4*)(p.conv_a_w + 512 + cb + c4 * 4);
      const float4 w2 = *(const float4*)(p.conv_a_w + 1024 + cb + c4 * 4);
      const float4 x0 = *(const float4*)(sCx + (tl + 0) * 68 + q4 * 16 + c4 * 4);
      const float4 x1 = *(const float4*)(sCx + (tl + 1) * 68 + q4 * 16 + c4 * 4);
      const float4 x2 = *(const float4*)(sCx + (tl + 2) * 68 + q4 * 16 + c4 * 4);
      ya[c4 * 4 + 0] = gb[c4 * 4 + 0] * (w0.x * x0.x + w1.x * x1.x + w2.x * x2.x);
      ya[c4 * 4 + 1] = gb[c4 * 4 + 1] * (w0.y * x0.y + w1.y * x1.y + w2.y * x2.y);
      ya[c4 * 4 + 2] = gb[c4 * 4 + 2] * (w0.z * x0.z + w1.z * x1.z + w2.z * x2.z);
      ya[c4 * 4 + 3] = gb[c4 * 4 + 3] * (w0.w * x0.w + w1.w * x1.w + w2.w * x2.w);
    }
#pragma unroll
    for (int c = 0; c < 16; ++c) ss += ya[c] * ya[c];
    ss += __shfl_xor(ss, 1, 64);
    ss += __shfl_xor(ss, 2, 64);
    const float rstd = rsqrtf(ss * (1.f / 64.f) + 1e-6f);
    unsigned o[8];
#pragma unroll
    for (int c2 = 0; c2 < 8; ++c2)
      o[c2] = pack2(ya[c2 * 2] * rstd * p.gn_a[cb + c2 * 2], ya[c2 * 2 + 1] * rstd * p.gn_a[cb + c2 * 2 + 1]);
    *(uint4*)(p.ycat + t * 1024 + cb) = make_uint4(o[0], o[1], o[2], o[3]);
    *(uint4*)(p.ycat + t * 1024 + cb + 8) = make_uint4(o[4], o[5], o[6], o[7]);
  }
  unsigned xp[8];
#pragma unroll
  for (int c4 = 0; c4 < 4; ++c4) {
    const float4 w0 = *(const float4*)(p.conv_b_w + cb + c4 * 4);
    const float4 w1 = *(const float4*)(p.conv_b_w + 512 + cb + c4 * 4);
    const float4 w2 = *(const float4*)(p.conv_b_w + 1024 + cb + c4 * 4);
    const float4 w3 = *(const float4*)(p.conv_b_w + 1536 + cb + c4 * 4);
    const float4 bb = *(const float4*)(p.conv_b_b + cb + c4 * 4);
    const float4 x0 = *(const float4*)(sXr + (tl + 0) * 68 + q4 * 16 + c4 * 4);
    const float4 x1 = *(const float4*)(sXr + (tl + 1) * 68 + q4 * 16 + c4 * 4);
    const float4 x2 = *(const float4*)(sXr + (tl + 2) * 68 + q4 * 16 + c4 * 4);
    const float4 x3 = *(const float4*)(sXr + (tl + 3) * 68 + q4 * 16 + c4 * 4);
    const float vx = w0.x * x0.x + w1.x * x1.x + w2.x * x2.x + w3.x * x3.x + bb.x;
    const float vy = w0.y * x0.y + w1.y * x1.y + w2.y * x2.y + w3.y * x3.y + bb.y;
    const float vz = w0.z * x0.z + w1.z * x1.z + w2.z * x2.z + w3.z * x3.z + bb.z;
    const float vw = w0.w * x0.w + w1.w * x1.w + w2.w * x2.w + w3.w * x3.w + bb.w;
    xp[c4 * 2] = pack2(vx, vy); xp[c4 * 2 + 1] = pack2(vz, vw);
  }
  __syncthreads();
  u16* sXp = (u16*)smem;
  *(uint4*)(smem + tl * 144 + q4 * 32) = make_uint4(xp[0], xp[1], xp[2], xp[3]);
  *(uint4*)(smem + tl * 144 + q4 * 32 + 16) = make_uint4(xp[4], xp[5], xp[6], xp[7]);
  __syncthreads();
  const int mt = w >> 1, nt = w & 1;
  f32x16 accR = zero16(), accI = zero16();
#pragma unroll
  for (int kk = 0; kk < 4; ++kk) {
    const bf16x8 a = *(const bf16x8*)(smem + (mt * 32 + (lane & 31)) * 144 + kk * 32 + (lane >> 5) * 16);
    const size_t fo = (size_t)((((h * 2 + nt) * 4 + kk) * 64 + lane)) * 8;
    const bf16x8 br = *(const bf16x8*)(p.WrF + fo);
    const bf16x8 bi = *(const bf16x8*)(p.WiF + fo);
    accR = mfma32(a, br, accR);
    accI = mfma32(a, bi, accI);
  }
  const int j = nt * 32 + (lane & 31);
  const int hc = h * 64 + j;
  float xv[16];
#pragma unroll
  for (int r = 0; r < 16; ++r) xv[r] = bf2f(sXp[(mt * 32 + crow(r, lane)) * 72 + j]);
  __syncthreads();
  float* sLa = (float*)smem;
  float* sU = (float*)(smem + 32768);
  {
    const float br_ = p.b_r[hc], bi_ = p.b_i[hc];
    const float sp = log1pf(expf(-p.lam[hc]));
#pragma unroll
    for (int r = 0; r < 16; ++r) {
      const int tl2 = mt * 32 + crow(r, lane);
      const float rr = sigm(accR[r] + br_);
      const float ii = sigm(accI[r] + bi_);
      const float la = -8.f * rr * sp;
      const float u = sqrtf(-expm1f(2.f * la)) * ii * xv[r];
      sLa[tl2 * 64 + j] = la;
      sU[tl2 * 64 + j] = u;
    }
  }
  __syncthreads();
  const int seg = tid >> 6, ch = tid & 63;
  float* sSegA = (float*)(smem + 65536);
  float* sSegH = sSegA + 512;
  {
    float cum = 0.f, hh = 0.f;
#pragma unroll
    for (int i = 0; i < 16; ++i) {
      const int ix = (seg * 16 + i) * 64 + ch;
      const float la = sLa[ix], u = sU[ix];
      hh = __expf(la) * hh + u;
      cum += la;
      sU[ix] = hh; sLa[ix] = cum;
    }
    sSegA[seg * 64 + ch] = cum; sSegH[seg * 64 + ch] = hh;
  }
  __syncthreads();
  {
    float cH = 0.f, cL = 0.f;
#pragma unroll
    for (int s2 = 0; s2 < 7; ++s2) {
      if (s2 < seg) {
        const float A = sSegA[s2 * 64 + ch];
        cH = __expf(A) * cH + sSegH[s2 * 64 + ch];
        cL += A;
      }
    }
#pragma unroll
    for (int i = 0; i < 16; ++i) {
      const int ix = (seg * 16 + i) * 64 + ch;
      const float cs = sLa[ix];
      const float lp = cs + cL;
      const float hl = sU[ix] + __expf(cs) * cH;
      const size_t go = (size_t)(t0 + seg * 16 + i) * 512 + h * 64 + ch;
      p.hloc[go] = f2bf(hl);
      p.logP[go] = f2bf(lp);
      if (seg == 7 && i == 15) {
        p.Hend[tile * 512 + h * 64 + ch] = hl;
        p.Pend[tile * 512 + h * 64 + ch] = lp;
      }
    }
  }
  __syncthreads();
}

DEV void p4_mixer2(const Params& p, int item, char* smem) {
  const int tid = threadIdx.x;
  const int tile = item >> 3, h = item & 7;
  const int t0 = tile * 128;
  const int b = tile >> 6, cidx = tile & 63;
  float* sSegA = (float*)smem;
  float* sSegH = sSegA + 512;
  float* sCarry = sSegH + 512;
  const int seg = tid >> 6, ch = tid & 63;
  {
    float A = 0.f, H = 0.f;
#pragma unroll
    for (int i = 0; i < 8; ++i) {
      const int c2 = seg * 8 + i;
      if (c2 < cidx) {
        const size_t o = (size_t)(b * 64 + c2) * 512 + h * 64 + ch;
        const float pl = p.Pend[o];
        H = __expf(pl) * H + p.Hend[o];
        A += pl;
      }
    }
    sSegA[seg * 64 + ch] = A; sSegH[seg * 64 + ch] = H;
  }
  __syncthreads();
  if (tid < 64) {
    float cH = 0.f;
#pragma unroll
    for (int s2 = 0; s2 < 8; ++s2) cH = __expf(sSegA[s2 * 64 + ch]) * cH + sSegH[s2 * 64 + ch];
    sCarry[ch] = cH;
  }
  __syncthreads();
  const int tl = tid >> 2, q4 = tid & 3;
  const size_t t = (size_t)t0 + tl;
  const int cb = h * 64 + q4 * 16;
  float hl[16], lp[16], gr[16], yb[16];
  unpack8(*(const uint4*)(p.hloc + t * 512 + cb), hl);
  unpack8(*(const uint4*)(p.hloc + t * 512 + cb + 8), hl + 8);
  unpack8(*(const uint4*)(p.logP + t * 512 + cb), lp);
  unpack8(*(const uint4*)(p.logP + t * 512 + cb + 8), lp + 8);
  unpack8(*(const uint4*)(p.z + t * 2560 + 2048 + cb), gr);
  unpack8(*(const uint4*)(p.z + t * 2560 + 2048 + cb + 8), gr + 8);
  float ss = 0.f;
#pragma unroll
  for (int c = 0; c < 16; ++c) {
    const float hv = hl[c] + __expf(lp[c]) * sCarry[q4 * 16 + c];
    yb[c] = hv * gelu_tanh(gr[c]);
    ss += yb[c] * yb[c];
  }
  ss += __shfl_xor(ss, 1, 64);
  ss += __shfl_xor(ss, 2, 64);
  const float rstd = rsqrtf(ss * (1.f / 64.f) + 1e-6f);
  unsigned o[8];
#pragma unroll
  for (int c2 = 0; c2 < 8; ++c2)
    o[c2] = pack2(yb[c2 * 2] * rstd * p.gn_b[cb + c2 * 2], yb[c2 * 2 + 1] * rstd * p.gn_b[cb + c2 * 2 + 1]);
  *(uint4*)(p.ycat + t * 1024 + 512 + cb) = make_uint4(o[0], o[1], o[2], o[3]);
  *(uint4*)(p.ycat + t * 1024 + 512 + cb + 8) = make_uint4(o[4], o[5], o[6], o[7]);
  __syncthreads();
}

DEV void p7_route(const Params& p, int item, char* smem) {
  const int tid = threadIdx.x, lane = tid & 63, w = tid >> 6;
  const int mt = item >> 3, hh = item & 7;
  const int m0 = mt * 128;
  f32x16 acc0 = zero16(), acc1 = zero16();
  gemm_core(p.h, p.WqT, m0, hh * 128, smem, acc0, acc1);
  u16* sQ = (u16*)smem;
  float* sS = (float*)(smem + 34816);
  unsigned* sTop = (unsigned*)(smem + 34816 + 33792);
  {
    const int wr = w >> 1, wc = w & 1;
#pragma unroll
    for (int r = 0; r < 16; ++r) {
      const int row = wr * 32 + crow(r, lane);
      sQ[row * 136 + wc * 64 + (lane & 31)] = f2bf(acc0[r]);
      sQ[row * 136 + wc * 64 + 32 + (lane & 31)] = f2bf(acc1[r]);
    }
  }
  __syncthreads();
  const int rg = lane >> 4, li = lane & 15;
#pragma unroll 1
  for (int chunk = 0; chunk < 4; ++chunk) {
    {
      const int c = w >> 2, nt = w & 3;
      f32x16 s = zero16();
#pragma unroll
      for (int kk = 0; kk < 4; ++kk) {
        const bf16x8 a = *(const bf16x8*)(smem + (chunk * 32 + (lane & 31)) * 272 +
                                          (c * 64 + kk * 16 + (lane >> 5) * 8) * 2);
        const bf16x8 bk = *(const bf16x8*)(p.keysF + (size_t)(((((hh * 2 + c) * 4 + nt) * 4 + kk) * 64 + lane)) * 8);
        s = mfma32(a, bk, s);
      }
#pragma unroll
      for (int r = 0; r < 16; ++r) sS[(c * 32 + crow(r, lane)) * 132 + nt * 32 + (lane & 31)] = s[r];
    }
    __syncthreads();
    const int tokl = w * 4 + rg;
    unsigned res[2];
#pragma unroll
    for (int c = 0; c < 2; ++c) {
      unsigned k[8];
#pragma unroll
      for (int jj = 0; jj < 8; ++jj) {
        const float v = sS[(c * 32 + tokl) * 132 + li + 16 * jj];
        k[jj] = (sortable(v) & ~127u) | (unsigned)(li + 16 * jj);
      }
      unsigned r_ = 0;
#pragma unroll
      for (int it = 0; it < 16; ++it) {
        unsigned m = max(max(max(k[0], k[1]), max(k[2], k[3])), max(max(k[4], k[5]), max(k[6], k[7])));
        m = row_max_u(m);
#pragma unroll
        for (int jj = 0; jj < 8; ++jj) k[jj] = (k[jj] == m) ? 0u : k[jj];
        r_ = (li == it) ? m : r_;
      }
      res[c] = r_;
    }
    unsigned* tp = sTop + (w * 4 + rg) * 32;
    tp[li] = res[0];
    tp[16 + li] = res[1];
    __syncthreads();
    {
      const float s0 = unsortable(res[0] & ~127u);
      unsigned ck[16];
#pragma unroll
      for (int bb = 0; bb < 16; ++bb) {
        const float s1 = unsortable(tp[16 + bb] & ~127u);
        ck[bb] = (sortable(s0 + s1) & ~255u) | (unsigned)(li * 16 + bb);
      }
      unsigned r_ = 0;
#pragma unroll
      for (int it = 0; it < 16; ++it) {
        unsigned m = ck[0];
#pragma unroll
        for (int bb = 1; bb < 16; ++bb) m = max(m, ck[bb]);
        m = row_max_u(m);
#pragma unroll
        for (int bb = 0; bb < 16; ++bb) ck[bb] = (ck[bb] == m) ? 0u : ck[bb];
        r_ = (li == it) ? m : r_;
      }
      const int pos = r_ & 255;
      const int i0 = tp[pos >> 4] & 127, i1 = tp[16 + (pos & 15)] & 127;
      const float bs = unsortable(r_ & ~255u);
      const float mx = unsortable(row_max_u(r_) & ~255u);
      const float e = __expf(bs - mx);
      const float sum = row_sum_f(e);
      const size_t tg = (size_t)m0 + chunk * 32 + tokl;
      p.idx[tg * 128 + hh * 16 + li] = i0 * 128 + i1;
      p.gsel[tg * 128 + hh * 16 + li] = e / sum;
    }
    __syncthreads();
  }
}

DEV void p8_peer(const Params& p, int item) {
  const int lane = threadIdx.x & 63, w = threadIdx.x >> 6;
  const size_t t = (size_t)item * 8 + w;
  float hf[16], acc[16];
  unpack8(*(const uint4*)(p.h + t * 1024 + lane * 8), hf);
  unpack8(*(const uint4*)(p.h + t * 1024 + 512 + lane * 8), hf + 8);
#pragma unroll
  for (int i = 0; i < 16; ++i) acc[i] = 0.f;
  const int id0 = p.idx[t * 128 + lane], id1 = p.idx[t * 128 + 64 + lane];
  const float g0 = p.gsel[t * 128 + lane], g1 = p.gsel[t * 128 + 64 + lane];
#pragma unroll 1
  for (int half = 0; half < 2; ++half) {
    const int iv = half ? id1 : id0;
    const int gv = __float_as_int(half ? g1 : g0);
#pragma unroll 4
    for (int e = 0; e < 64; ++e) {
      const int id = __builtin_amdgcn_readlane(iv, e);
      const float gg = __int_as_float(__builtin_amdgcn_readlane(gv, e));
      const uint4* up = (const uint4*)(p.Ub + (size_t)id * 1024);
      const uint4* vp = (const uint4*)(p.Vb + (size_t)id * 1024);
      const uint4 ua = up[lane], ub = up[64 + lane];
      const uint4 va = vp[lane], vb = vp[64 + lane];
      float uf[16];
      unpack8(ua, uf); unpack8(ub, uf + 8);
      float d = 0.f;
#pragma unroll
      for (int i = 0; i < 16; ++i) d += hf[i] * uf[i];
      d = row_sum_f(d);
      d = __int_as_float(__builtin_amdgcn_readlane(__float_as_int(d), 0)) +
          __int_as_float(__builtin_amdgcn_readlane(__float_as_int(d), 16)) +
          __int_as_float(__builtin_amdgcn_readlane(__float_as_int(d), 32)) +
          __int_as_float(__builtin_amdgcn_readlane(__float_as_int(d), 48));
      const float act = 0.5f * d * (1.f + erff(d * 0.7071067811865476f));
      const float cf = gg * act;
      float vf[16];
      unpack8(va, vf); unpack8(vb, vf + 8);
#pragma unroll
      for (int i = 0; i < 16; ++i) acc[i] += cf * vf[i];
    }
  }
  const int b = (int)(t >> 13);
  const float* g2 = p.ada + b * 6144 + 5120;
  float x2[16];
  float ss = 0.f;
#pragma unroll
  for (int q = 0; q < 4; ++q) {
    const int col = (q >> 1) * 512 + lane * 8 + (q & 1) * 4;
    const float4 xv = *(const float4*)(p.x1 + t * 1024 + col);
    const float4 gv = *(const float4*)(g2 + col);
    x2[q * 4 + 0] = xv.x + gv.x * acc[q * 4 + 0];
    x2[q * 4 + 1] = xv.y + gv.y * acc[q * 4 + 1];
    x2[q * 4 + 2] = xv.z + gv.z * acc[q * 4 + 2];
    x2[q * 4 + 3] = xv.w + gv.w * acc[q * 4 + 3];
  }
#pragma unroll
  for (int i = 0; i < 16; ++i) ss += x2[i] * x2[i];
  ss = wave_allsum(ss);
  const float rstd = rsqrtf(ss * (1.f / 1024.f) + 1e-6f);
#pragma unroll
  for (int q = 0; q < 4; ++q) {
    const int col = (q >> 1) * 512 + lane * 8 + (q & 1) * 4;
    const float4 fg = *(const float4*)(p.final_g + col);
    *(float4*)(p.out + t * 1024 + col) =
        make_float4(x2[q * 4 + 0] * rstd * fg.x, x2[q * 4 + 1] * rstd * fg.y,
                    x2[q * 4 + 2] * rstd * fg.z, x2[q * 4 + 3] * rstd * fg.w);
  }
}

DEV int xcd_swz(int v, int n) { return (v & 7) * (n >> 3) + (v >> 3); }

template <int PH> DEV void run_phase(const Params& p, char* smem) {
  constexpr int n = PH == 0 ? P0_ITEMS : PH == 1 ? 1024 : PH == 2 ? 10240 : PH == 3 ? 4096 : PH == 4 ? 4096
                  : PH == 5 ? 4096 : PH == 6 ? 1024 : PH == 7 ? 4096 : 8192;
  for (int v = blockIdx.x; v < n; v += gridDim.x) {
    if (PH == 0) phase0(p, v, smem);
    else if (PH == 1) p_norm_mod(p.x, p.norm1_g, p.ada, 0, 1024, p.h, v);
    else if (PH == 2) p2_gemm1(p, xcd_swz(v, n), smem);
    else if (PH == 3) p3_mixer1(p, v, smem);
    else if (PH == 4) p4_mixer2(p, v, smem);
    else if (PH == 5) p5_gemm2(p, xcd_swz(v, n), smem);
    else if (PH == 6) p_norm_mod(p.x1, p.norm2_g, p.ada, 3072, 4096, p.h, v);
    else if (PH == 7) p7_route(p, xcd_swz(v, n), smem);
    else p8_peer(p, v);
  }
}

#if MULTI_LAUNCH
template <int PH> __global__ void __launch_bounds__(NT) k_phase(Params p) {
  extern __shared__ __attribute__((aligned(16))) char smem[];
  run_phase<PH>(p, smem);
}
#else
__global__ void __launch_bounds__(NT) mega(Params p) {
  extern __shared__ __attribute__((aligned(16))) char smem[];
  cg::grid_group grid = cg::this_grid();
  run_phase<0>(p, smem); grid.sync();
  run_phase<1>(p, smem); grid.sync();
  run_phase<2>(p, smem); grid.sync();
  run_phase<3>(p, smem); grid.sync();
  run_phase<4>(p, smem); grid.sync();
  run_phase<5>(p, smem); grid.sync();
  run_phase<6>(p, smem); grid.sync();
  run_phase<7>(p, smem); grid.sync();
  run_phase<8>(p, smem);
}
#endif

extern "C" void kernel_launch(void* const* d_in, const int* in_sizes, int n_in, void* d_out, int out_size,
                              void* d_ws, size_t ws_size, hipStream_t stream) {
  Params p{};
  const float* const* in = (const float* const*)d_in;
  p.x = in[0]; p.c = in[1]; p.w_ada = in[2]; p.b_ada = in[3]; p.norm1_g = in[4]; p.w_in = in[5];
  p.conv_a_w = in[6]; p.conv_b_w = in[7]; p.conv_b_b = in[8]; p.w_r = in[9]; p.b_r = in[10];
  p.w_i = in[11]; p.b_i = in[12]; p.lam = in[13]; p.gn_a = in[14]; p.gn_b = in[15]; p.w_out = in[16];
  p.norm2_g = in[17]; p.w_q = in[18]; p.sub_keys = in[19]; p.expert_u = in[20]; p.expert_v = in[21];
  p.final_g = in[22];
  p.out = (float*)d_out;
  char* ws = (char*)d_ws;
  size_t off = 0;
  auto alloc = [&](size_t bytes) { void* r = ws + off; off += (bytes + 255) & ~(size_t)255; return r; };
  p.ada = (float*)alloc(8 * 6144 * 4);
  p.WinT = (u16*)alloc((size_t)2560 * 1024 * 2);
  p.WoutT = (u16*)alloc((size_t)1024 * 1024 * 2);
  p.WqT = (u16*)alloc((size_t)1024 * 1024 * 2);
  p.keysF = (u16*)alloc(131072 * 2);
  p.WrF = (u16*)alloc(32768 * 2);
  p.WiF = (u16*)alloc(32768 * 2);
  p.Ub = (u16*)alloc((size_t)16384 * 1024 * 2);
  p.Vb = (u16*)alloc((size_t)16384 * 1024 * 2);
  p.h = (u16*)alloc((size_t)T_ * 1024 * 2);
  p.z = (u16*)alloc((size_t)T_ * 2560 * 2);
  p.ycat = (u16*)alloc((size_t)T_ * 1024 * 2);
  p.hloc = (u16*)alloc((size_t)T_ * 512 * 2);
  p.logP = (u16*)alloc((size_t)T_ * 512 * 2);
  p.Hend = (float*)alloc(512 * 512 * 4);
  p.Pend = (float*)alloc(512 * 512 * 4);
  p.x1 = (float*)p.z;
  p.idx = (int*)p.hloc;
  p.gsel = (float*)p.logP;
#if MULTI_LAUNCH
  const int grid = 1024;
#define LAUNCH_PH(PH)                                                                              \
  hipFuncSetAttribute((const void*)k_phase<PH>, hipFuncAttributeMaxDynamicSharedMemorySize, LDS_BYTES); \
  k_phase<PH><<<grid, NT, LDS_BYTES, stream>>>(p);
  LAUNCH_PH(0) LAUNCH_PH(1) LAUNCH_PH(2) LAUNCH_PH(3) LAUNCH_PH(4)
  LAUNCH_PH(5) LAUNCH_PH(6) LAUNCH_PH(7) LAUNCH_PH(8)
#else
  static int grid_blocks = 0;
  hipFuncSetAttribute((const void*)mega, hipFuncAttributeMaxDynamicSharedMemorySize, LDS_BYTES);
  if (!grid_blocks) {
    int dev = 0, cus = 0, per_cu = 0;
    hipGetDevice(&dev);
    hipDeviceGetAttribute(&cus, hipDeviceAttributeMultiprocessorCount, dev);
    hipOccupancyMaxActiveBlocksPerMultiprocessor(&per_cu, mega, NT, LDS_BYTES);
    grid_blocks = cus * per_cu;
  }
  void* args[] = {&p};
  hipError_t e = hipLaunchCooperativeKernel((void*)mega, dim3(grid_blocks), dim3(NT), args, LDS_BYTES, stream);
  if (e != hipSuccess) fprintf(stderr, "cooperative launch failed: %s (grid %d)\n", hipGetErrorString(e), grid_blocks);
#endif
}
```

```cpp
#include <hip/hip_runtime.h>
#include <hip/hip_cooperative_groups.h>
#include <cstdio>
namespace cg = cooperative_groups;

#ifndef MULTI_LAUNCH
#define MULTI_LAUNCH 0
#endif

typedef unsigned short u16;
using bf16x8 = __attribute__((ext_vector_type(8))) short;
using f32x16 = __attribute__((ext_vector_type(16))) float;

#define DEV __device__ __forceinline__
DEV int tidx() { int t = threadIdx.x; asm volatile("" : "+v"(t)); return t; }

constexpr int NT = 512;
constexpr int T_ = 65536;
constexpr int LDS_PHASE = 73728;
constexpr int LDS_BYTES = LDS_PHASE + 16;
constexpr int LROW = 144;
constexpr int STAGE = 256 * LROW;

struct Params {
  const float *x, *c, *w_ada, *b_ada, *norm1_g, *w_in, *conv_a_w, *conv_b_w, *conv_b_b;
  const float *w_r, *b_r, *w_i, *b_i, *lam, *gn_a, *gn_b, *w_out, *norm2_g, *w_q, *sub_keys;
  const float *expert_u, *expert_v, *final_g;
  float* out;
  float* ada;
  u16 *WinT, *WoutT, *WqT;
  u16 *keysF, *WrF, *WiF;
  unsigned char *Ub, *Vb;
  float *uS, *vS;
  u16 *h;
  u16 *z;
  u16 *ycat;
  u16 *hloc, *logP;
  float *Hend, *Pend;
  u16 *x1b;
  u16 *x2b;
  float* gsel;
  unsigned short* Pd;
  unsigned short* coef16;
  unsigned short* idx16;
  signed char* h8;
  float* hS;
  float* ssq;
  unsigned* bar;
  int reps; int pad_;
};

DEV u16 f2bf(float f) {
  unsigned u = __float_as_uint(f);
  u += 0x7FFFu + ((u >> 16) & 1u);
  return (u16)(u >> 16);
}
DEV float bf2f(u16 h) { return __uint_as_float(((unsigned)h) << 16); }
DEV unsigned pack2(float a, float b) { return (unsigned)f2bf(a) | ((unsigned)f2bf(b) << 16); }
DEV void unpack8(uint4 v, float* f) {
  f[0] = __uint_as_float(v.x << 16); f[1] = __uint_as_float(v.x & 0xFFFF0000u);
  f[2] = __uint_as_float(v.y << 16); f[3] = __uint_as_float(v.y & 0xFFFF0000u);
  f[4] = __uint_as_float(v.z << 16); f[5] = __uint_as_float(v.z & 0xFFFF0000u);
  f[6] = __uint_as_float(v.w << 16); f[7] = __uint_as_float(v.w & 0xFFFF0000u);
}
DEV unsigned pack_i8x4(float a, float b, float c, float d) {
  const int qa = (int)rintf(fminf(fmaxf(a, -127.f), 127.f)), qb = (int)rintf(fminf(fmaxf(b, -127.f), 127.f));
  const int qc = (int)rintf(fminf(fmaxf(c, -127.f), 127.f)), qd = (int)rintf(fminf(fmaxf(d, -127.f), 127.f));
  return (unsigned)(qa & 0xFF) | ((unsigned)(qb & 0xFF) << 8) | ((unsigned)(qc & 0xFF) << 16) | ((unsigned)(qd & 0xFF) << 24);
}
DEV float sigm(float x) { return 1.f / (1.f + __expf(-x)); }
DEV float gelu_tanh(float x) {
  float u = 0.7978845608028654f * (x + 0.044715f * x * x * x);
  float t = 1.f - 2.f / (1.f + __expf(2.f * u));
  return 0.5f * x * (1.f + t);
}
DEV float wave_allsum(float v) {
#pragma unroll
  for (int o = 32; o > 0; o >>= 1) v += __shfl_xor(v, o, 64);
  return v;
}
template <int CTRL> DEV unsigned dpp_u(unsigned v) {
  return (unsigned)__builtin_amdgcn_update_dpp((int)v, (int)v, CTRL, 0xF, 0xF, true);
}
DEV unsigned row_max_u(unsigned v) {
  v = max(v, dpp_u<0xB1>(v));
  v = max(v, dpp_u<0x4E>(v));
  v = max(v, dpp_u<0x141>(v));
  v = max(v, dpp_u<0x140>(v));
  return v;
}
DEV float row_sum_f(float v) {
  v += __uint_as_float(dpp_u<0xB1>(__float_as_uint(v)));
  v += __uint_as_float(dpp_u<0x4E>(__float_as_uint(v)));
  v += __uint_as_float(dpp_u<0x141>(__float_as_uint(v)));
  v += __uint_as_float(dpp_u<0x140>(__float_as_uint(v)));
  return v;
}
DEV unsigned sortable(float f) {
  unsigned k = __float_as_uint(f);
  return (k & 0x80000000u) ? ~k : (k | 0x80000000u);
}
DEV float unsortable(unsigned k) {
  return __uint_as_float((k & 0x80000000u) ? (k & 0x7FFFFFFFu) : ~k);
}
DEV f32x16 mfma32(bf16x8 a, bf16x8 b, f32x16 c) {
  return __builtin_amdgcn_mfma_f32_32x32x16_bf16(a, b, c, 0, 0, 0);
}
DEV int crow(int reg, int lane) { return (reg & 3) + 8 * (reg >> 2) + 4 * (lane >> 5); }

DEV void p0_ada(const Params& p, int item, char* smem) {
  float* sRed = (float*)smem;
  float* sC = (float*)(smem + 16384);
  const int tid = tidx(), w = tid >> 6, lane = tid & 63;
  const int col = item * 64 + lane;
#pragma unroll
  for (int i = 0; i < 16; ++i) {
    const int e = lane + 64 * i, b = e >> 7, kk = e & 127;
    const float cv = p.c[b * 1024 + w * 128 + kk];
    sC[w * 1024 + e] = cv / (1.f + __expf(-cv));
  }
  __syncthreads();
  float acc[8];
#pragma unroll
  for (int b = 0; b < 8; ++b) acc[b] = 0.f;
  const float* wp = p.w_ada + (size_t)(w * 128) * 6144 + col;
  const float* sc = sC + w * 1024;
#pragma unroll 64
  for (int kk = 0; kk < 128; ++kk) {
    const float wv = wp[(size_t)kk * 6144];
#pragma unroll
    for (int b = 0; b < 8; ++b) acc[b] += sc[b * 128 + kk] * wv;
  }
#pragma unroll
  for (int b = 0; b < 8; ++b) sRed[(w * 8 + b) * 64 + lane] = acc[b];
  __syncthreads();
  {
    const int b = tid >> 6, cl = tid & 63;
    float sum = 0.f;
#pragma unroll
    for (int w2 = 0; w2 < 8; ++w2) sum += sRed[(w2 * 8 + b) * 64 + cl];
    p.ada[b * 6144 + item * 64 + cl] = sum + p.b_ada[item * 64 + cl];
  }
  __syncthreads();
}

DEV void p0_transpose(const float* W, int K, int N, u16* Wt, int item, char* smem) {
  float* sT = (float*)smem;
  const int ntn = N >> 6;
  const int nt = item % ntn, kt = item / ntn;
  const int tid = tidx();
#pragma unroll
  for (int i = 0; i < 8; ++i) {
    const int e = tid + i * NT, r = e >> 6, c = e & 63;
    sT[r * 65 + c] = W[(size_t)(kt * 64 + r) * N + nt * 64 + c];
  }
  __syncthreads();
#pragma unroll
  for (int i = 0; i < 8; ++i) {
    const int e = tid + i * NT, r = e >> 6, c = e & 63;
    Wt[(size_t)(nt * 64 + r) * K + kt * 64 + c] = f2bf(sT[c * 65 + r]);
  }
  __syncthreads();
}

DEV void p0_keys(const Params& p, int item) {
#pragma unroll
  for (int i = 0; i < 8; ++i) {
    const int o = item * 4096 + i * NT + tidx();
    const int j = o & 7, lane = (o >> 3) & 63, kk = (o >> 9) & 3, nt = (o >> 11) & 3, hc = o >> 13;
    const int n = nt * 32 + (lane & 31), k = kk * 16 + (lane >> 5) * 8 + j;
    p.keysF[o] = f2bf(p.sub_keys[(hc * 128 + n) * 64 + k]);
  }
}
DEV void p0_gate(const float* W, u16* WF, int item) {
#pragma unroll
  for (int i = 0; i < 8; ++i) {
    const int o = item * 4096 + i * NT + tidx();
    const int j = o & 7, lane = (o >> 3) & 63, kk = (o >> 9) & 3, nt = (o >> 11) & 1, hh = o >> 12;
    const int n = nt * 32 + (lane & 31), k = kk * 16 + (lane >> 5) * 8 + j;
    WF[o] = f2bf(W[(hh * 64 + k) * 64 + n]);
  }
}
DEV void p0_expert(const float* src, unsigned char* dst, float* scl, int item) {
  const int lane = tidx() & 63, w = tidx() >> 6;
  const size_t e = (size_t)item * 8 + w;
  const float* rp = src + e * 1024 + lane * 16;
  float4 v[4];
  float am = 0.f;
#pragma unroll
  for (int i = 0; i < 4; ++i) {
    v[i] = *(const float4*)(rp + i * 4);
    am = fmaxf(am, fmaxf(fmaxf(fabsf(v[i].x), fabsf(v[i].y)), fmaxf(fabsf(v[i].z), fabsf(v[i].w))));
  }
#pragma unroll
  for (int o = 32; o > 0; o >>= 1) am = fmaxf(am, __shfl_xor(am, o, 64));
  am = fmaxf(am, 1e-30f);
  const float sc = 448.f / am;
  unsigned q[4];
#pragma unroll
  for (int i = 0; i < 4; ++i) {
    int t = __builtin_amdgcn_cvt_pk_fp8_f32(v[i].x * sc, v[i].y * sc, 0, false);
    t = __builtin_amdgcn_cvt_pk_fp8_f32(v[i].z * sc, v[i].w * sc, t, true);
    q[i] = (unsigned)t;
  }
  *(uint4*)(dst + (size_t)(lane >> 3) * (16384 * 128) + e * 128 + (lane & 7) * 16) = make_uint4(q[0], q[1], q[2], q[3]);
  if (lane == 0) scl[e] = am * (1.f / 448.f);
}
DEV void p0_expert_i8(const float* src, unsigned char* dst, float* scl, int item) {
  const int lane = tidx() & 63, w = tidx() >> 6;
  const size_t e = (size_t)item * 8 + w;
  const float* rp = src + e * 1024 + lane * 16;
  float4 v[4];
  float am = 0.f;
#pragma unroll
  for (int i = 0; i < 4; ++i) {
    v[i] = *(const float4*)(rp + i * 4);
    am = fmaxf(am, fmaxf(fmaxf(fabsf(v[i].x), fabsf(v[i].y)), fmaxf(fabsf(v[i].z), fabsf(v[i].w))));
  }
#pragma unroll
  for (int o = 32; o > 0; o >>= 1) am = fmaxf(am, __shfl_xor(am, o, 64));
  am = fmaxf(am, 1e-30f);
  const float sc = 127.f / am;
  unsigned q[4];
#pragma unroll
  for (int i = 0; i < 4; ++i) q[i] = pack_i8x4(v[i].x * sc, v[i].y * sc, v[i].z * sc, v[i].w * sc);
  *(uint4*)(dst + (size_t)(lane >> 3) * (16384 * 128) + e * 128 + (lane & 7) * 16) = make_uint4(q[0], q[1], q[2], q[3]);
  if (lane == 0) scl[e] = am * (1.f / 127.f);
}
constexpr int P0_ITEMS = 96 + 640 + 256 + 256 + 32 + 8 + 8 + 2048 + 2048;
DEV void phase0(const Params& p, int item, char* smem) {
  if (item < 96) { p0_ada(p, item, smem); return; }
  item -= 96;
  if (item < 640) { p0_transpose(p.w_in, 1024, 2560, p.WinT, item, smem); return; }
  item -= 640;
  if (item < 256) { p0_transpose(p.w_out, 1024, 1024, p.WoutT, item, smem); return; }
  item -= 256;
  if (item < 256) { p0_transpose(p.w_q, 1024, 1024, p.WqT, item, smem); return; }
  item -= 256;
  if (item < 32) { p0_keys(p, item); return; }
  item -= 32;
  if (item < 8) { p0_gate(p.w_r, p.WrF, item); return; }
  item -= 8;
  if (item < 8) { p0_gate(p.w_i, p.WiF, item); return; }
  item -= 8;
  if (item < 2048) { p0_expert_i8(p.expert_u, p.Ub, p.uS, item); return; }
  item -= 2048;
  p0_expert(p.expert_v, p.Vb, p.vS, item);
}

template <bool BF> DEV void p_norm_mod(const void* xin_, const float* g, const float* ada, int sh_off, int sc_off,
                    u16* hout, signed char* h8out, float* hSout, int item) {
  const int tid = tidx(), lane = tid & 63, w = tid >> 6;
  const int t0 = item * 64 + w * 8;
  const int b = t0 >> 13;
  float4 gg[4], sc[4], sh[4];
#pragma unroll
  for (int i = 0; i < 4; ++i) {
    gg[i] = *(const float4*)(g + i * 256 + lane * 4);
    sc[i] = *(const float4*)(ada + b * 6144 + sc_off + i * 256 + lane * 4);
    sh[i] = *(const float4*)(ada + b * 6144 + sh_off + i * 256 + lane * 4);
    gg[i].x *= (1.f + sc[i].x); gg[i].y *= (1.f + sc[i].y); gg[i].z *= (1.f + sc[i].z); gg[i].w *= (1.f + sc[i].w);
  }
#pragma unroll 2
  for (int tt = 0; tt < 8; ++tt) {
    const size_t t = t0 + tt;
    float4 xv[4];
    float ss = 0.f;
#pragma unroll
    for (int i = 0; i < 4; ++i) {
      if (BF) {
        const uint2 r2 = *(const uint2*)((const u16*)xin_ + t * 1024 + i * 256 + lane * 4);
        xv[i] = make_float4(__uint_as_float(r2.x << 16), __uint_as_float(r2.x & 0xFFFF0000u),
                            __uint_as_float(r2.y << 16), __uint_as_float(r2.y & 0xFFFF0000u));
      } else {
        xv[i] = *(const float4*)((const float*)xin_ + t * 1024 + i * 256 + lane * 4);
      }
      ss += xv[i].x * xv[i].x + xv[i].y * xv[i].y + xv[i].z * xv[i].z + xv[i].w * xv[i].w;
    }
    ss = wave_allsum(ss);
    const float rstd = rsqrtf(ss * (1.f / 1024.f) + 1e-6f);
    float am = 0.f;
#pragma unroll
    for (int i = 0; i < 4; ++i) {
      xv[i].x = xv[i].x * rstd * gg[i].x + sh[i].x; xv[i].y = xv[i].y * rstd * gg[i].y + sh[i].y;
      xv[i].z = xv[i].z * rstd * gg[i].z + sh[i].z; xv[i].w = xv[i].w * rstd * gg[i].w + sh[i].w;
      uint2 o;
      o.x = pack2(xv[i].x, xv[i].y);
      o.y = pack2(xv[i].z, xv[i].w);
      *(uint2*)(hout + t * 1024 + i * 256 + lane * 4) = o;
      if (BF) am = fmaxf(am, fmaxf(fmaxf(fabsf(xv[i].x), fabsf(xv[i].y)), fmaxf(fabsf(xv[i].z), fabsf(xv[i].w))));
    }
    if (BF) {
#pragma unroll
      for (int o = 32; o > 0; o >>= 1) am = fmaxf(am, __shfl_xor(am, o, 64));
      am = fmaxf(am, 1e-30f);
      const float qs = 127.f / am;
#pragma unroll
      for (int i = 0; i < 4; ++i)
        *(unsigned*)(h8out + t * 1024 + i * 256 + lane * 4) = pack_i8x4(xv[i].x * qs, xv[i].y * qs, xv[i].z * qs, xv[i].w * qs);
      if (lane == 0) hSout[t] = am * (1.f / 127.f);
    }
  }
}

DEV void gemm_core(const u16* __restrict__ A, const u16* __restrict__ Bt, int m0, int n0, char* smem,
                   f32x16& acc0, f32x16& acc1) {
  const int tid = tidx(), lane = tid & 63, w = tid >> 6, wr = w >> 1, wc = w & 1;
  const int lrow = tid >> 3, lc = tid & 7;
  const u16* ga = A + (size_t)(m0 + lrow) * 1024 + lc * 8;
  const u16* gb = Bt + (size_t)(n0 + lrow) * 1024 + lc * 8;
  const int lw = lrow * LROW + lc * 16;
  uint4 pa0, pa1, pb0, pb1, qa0, qa1, qb0, qb1;
  {
    const uint4 ra0 = *(const uint4*)ga, ra1 = *(const uint4*)(ga + 64 * 1024);
    const uint4 rb0 = *(const uint4*)gb, rb1 = *(const uint4*)(gb + 64 * 1024);
    __builtin_amdgcn_sched_barrier(0);
    pa0 = *(const uint4*)(ga + 64); pa1 = *(const uint4*)(ga + 64 * 1024 + 64);
    pb0 = *(const uint4*)(gb + 64); pb1 = *(const uint4*)(gb + 64 * 1024 + 64);
    __builtin_amdgcn_sched_barrier(0);
    qa0 = *(const uint4*)(ga + 128); qa1 = *(const uint4*)(ga + 64 * 1024 + 128);
    qb0 = *(const uint4*)(gb + 128); qb1 = *(const uint4*)(gb + 64 * 1024 + 128);
    __builtin_amdgcn_sched_barrier(0);
    *(uint4*)(smem + lw) = ra0;
    *(uint4*)(smem + lw + 64 * LROW) = ra1;
    *(uint4*)(smem + lw + 128 * LROW) = rb0;
    *(uint4*)(smem + lw + 192 * LROW) = rb1;
  }
  __syncthreads();
  const int a_off = (wr * 32 + (lane & 31)) * LROW + (lane >> 5) * 16;
  const int b_off = (128 + wc * 64 + (lane & 31)) * LROW + (lane >> 5) * 16;
#define GC128_COMPUTE(CUR)                                                              \
  _Pragma("unroll") for (int kk = 0; kk < 4; ++kk) {                                    \
    const bf16x8 a = *(const bf16x8*)((CUR) + a_off + kk * 32);                         \
    const bf16x8 b0 = *(const bf16x8*)((CUR) + b_off + kk * 32);                        \
    const bf16x8 b1 = *(const bf16x8*)((CUR) + b_off + 32 * LROW + kk * 32);            \
    acc0 = mfma32(a, b0, acc0);                                                         \
    acc1 = mfma32(a, b1, acc1);                                                         \
  }
#pragma unroll 1
  for (int kt = 0; kt < 16; kt += 2) {
    char* buf0 = smem;
    char* buf1 = smem + STAGE;
    GC128_COMPUTE(buf0)
    {
      *(uint4*)(buf1 + lw) = pa0;
      *(uint4*)(buf1 + lw + 64 * LROW) = pa1;
      *(uint4*)(buf1 + lw + 128 * LROW) = pb0;
      *(uint4*)(buf1 + lw + 192 * LROW) = pb1;
    }
    {
      const int ko = min(kt + 3, 15) * 64;
      pa0 = *(const uint4*)(ga + ko); pa1 = *(const uint4*)(ga + 64 * 1024 + ko);
      pb0 = *(const uint4*)(gb + ko); pb1 = *(const uint4*)(gb + 64 * 1024 + ko);
    }
    __syncthreads();
    GC128_COMPUTE(buf1)
    {
      *(uint4*)(buf0 + lw) = qa0;
      *(uint4*)(buf0 + lw + 64 * LROW) = qa1;
      *(uint4*)(buf0 + lw + 128 * LROW) = qb0;
      *(uint4*)(buf0 + lw + 192 * LROW) = qb1;
    }
    {
      const int ko = min(kt + 4, 15) * 64;
      qa0 = *(const uint4*)(ga + ko); qa1 = *(const uint4*)(ga + 64 * 1024 + ko);
      qb0 = *(const uint4*)(gb + ko); qb1 = *(const uint4*)(gb + 64 * 1024 + ko);
    }
    __syncthreads();
  }
#undef GC128_COMPUTE
}
DEV f32x16 zero16() {
  f32x16 z;
#pragma unroll
  for (int i = 0; i < 16; ++i) z[i] = 0.f;
  return z;
}

constexpr int LROW2 = 80;
constexpr int STAGE2 = 384 * LROW2;
DEV void gemm_core256(const u16* __restrict__ A, const u16* __restrict__ Bt, int m0, int n0, char* smem,
                      f32x16 (&acc)[2][2]) {
  const int tid = tidx(), lane = tid & 63, w = tid >> 6, wr = w >> 1, wc = w & 1;
  const int lrow = tid >> 2, lc = tid & 3;
  const u16* ga = A + (size_t)(m0 + lrow) * 1024 + lc * 8;
  const u16* gb = Bt + (size_t)(n0 + lrow) * 1024 + lc * 8;
  const int lw = lrow * LROW2 + lc * 16;
  uint4 pa0, pa1, pb0, qa0, qa1, qb0;
  {
    const uint4 ra0 = *(const uint4*)ga, ra1 = *(const uint4*)(ga + 128 * 1024), rb0 = *(const uint4*)gb;
    __builtin_amdgcn_sched_barrier(0);
    pa0 = *(const uint4*)(ga + 32); pa1 = *(const uint4*)(ga + 128 * 1024 + 32); pb0 = *(const uint4*)(gb + 32);
    __builtin_amdgcn_sched_barrier(0);
    qa0 = *(const uint4*)(ga + 64); qa1 = *(const uint4*)(ga + 128 * 1024 + 64); qb0 = *(const uint4*)(gb + 64);
    __builtin_amdgcn_sched_barrier(0);
    *(uint4*)(smem + lw) = ra0;
    *(uint4*)(smem + lw + 128 * LROW2) = ra1;
    *(uint4*)(smem + lw + 256 * LROW2) = rb0;
  }
  __syncthreads();
  const int a_off = (wr * 64 + (lane & 31)) * LROW2 + (lane >> 5) * 16;
  const int b_off = (256 + wc * 64 + (lane & 31)) * LROW2 + (lane >> 5) * 16;
#define GC256_COMPUTE(CUR)                                                              \
  _Pragma("unroll") for (int kk = 0; kk < 2; ++kk) {                                    \
    const bf16x8 a0 = *(const bf16x8*)((CUR) + a_off + kk * 32);                        \
    const bf16x8 a1 = *(const bf16x8*)((CUR) + a_off + 32 * LROW2 + kk * 32);           \
    const bf16x8 b0 = *(const bf16x8*)((CUR) + b_off + kk * 32);                        \
    const bf16x8 b1 = *(const bf16x8*)((CUR) + b_off + 32 * LROW2 + kk * 32);           \
    acc[0][0] = mfma32(a0, b0, acc[0][0]);                                              \
    acc[0][1] = mfma32(a0, b1, acc[0][1]);                                              \
    acc[1][0] = mfma32(a1, b0, acc[1][0]);                                              \
    acc[1][1] = mfma32(a1, b1, acc[1][1]);                                              \
  }
#pragma unroll 1
  for (int kt = 0; kt < 32; kt += 2) {
    char* buf0 = smem;
    char* buf1 = smem + STAGE2;
    GC256_COMPUTE(buf0)
    {
      *(uint4*)(buf1 + lw) = pa0;
      *(uint4*)(buf1 + lw + 128 * LROW2) = pa1;
      *(uint4*)(buf1 + lw + 256 * LROW2) = pb0;
    }
    {
      const int ko = min(kt + 3, 31) * 32;
      pa0 = *(const uint4*)(ga + ko); pa1 = *(const uint4*)(ga + 128 * 1024 + ko); pb0 = *(const uint4*)(gb + ko);
    }
    __syncthreads();
    GC256_COMPUTE(buf1)
    {
      *(uint4*)(buf0 + lw) = qa0;
      *(uint4*)(buf0 + lw + 128 * LROW2) = qa1;
      *(uint4*)(buf0 + lw + 256 * LROW2) = qb0;
    }
    {
      const int ko = min(kt + 4, 31) * 32;
      qa0 = *(const uint4*)(ga + ko); qa1 = *(const uint4*)(ga + 128 * 1024 + ko); qb0 = *(const uint4*)(gb + ko);
    }
    __syncthreads();
  }
#undef GC256_COMPUTE
}
DEV void stage_acc256(char* smem, const f32x16 (&acc)[2][2], int half) {
  float* sO = (float*)smem;
  const int tid = tidx(), lane = tid & 63, w = tid >> 6, wr = w >> 1, wc = w & 1;
  if ((wr >> 1) == half) {
    const int rb = (wr & 1) * 64, cb = wc * 64 + (lane & 31);
#pragma unroll
    for (int mi = 0; mi < 2; ++mi)
#pragma unroll
      for (int r = 0; r < 16; ++r) {
        const int row = rb + mi * 32 + crow(r, lane);
        sO[row * 132 + cb] = acc[mi][0][r];
        sO[row * 132 + cb + 32] = acc[mi][1][r];
      }
  }
  __syncthreads();
}
DEV void p2_gemm1(const Params& p, int item, char* smem) {
  const int xq = item / 640, j = item % 640;
  const int gid = j / 160, r = j % 160;
  const int mt = xq * 32 + gid * 8 + (r & 7), nt = r >> 3;
  f32x16 acc[2][2] = {{zero16(), zero16()}, {zero16(), zero16()}};
  gemm_core256(p.h, p.WinT, mt * 256, nt * 128, smem, acc);
  const float* sO = (const float*)smem;
  const int tid = tidx();
#pragma unroll
  for (int half = 0; half < 2; ++half) {
    stage_acc256(smem, acc, half);
#pragma unroll
    for (int i = 0; i < 4; ++i) {
      const int q = tid + i * NT, row = q >> 4, c8 = q & 15;
      const float4 a = *(const float4*)(sO + row * 132 + c8 * 8);
      const float4 b = *(const float4*)(sO + row * 132 + c8 * 8 + 4);
      *(uint4*)(p.z + (size_t)(mt * 256 + half * 128 + row) * 2560 + nt * 128 + c8 * 8) =
          make_uint4(pack2(a.x, a.y), pack2(a.z, a.w), pack2(b.x, b.y), pack2(b.z, b.w));
    }
    __syncthreads();
  }
}
DEV void p5_gemm2(const Params& p, int item, char* smem) {
  const int mt = item >> 3, nt = item & 7;
  f32x16 acc[2][2] = {{zero16(), zero16()}, {zero16(), zero16()}};
  gemm_core256(p.ycat, p.WoutT, mt * 256, nt * 128, smem, acc);
  const float* sO = (const float*)smem;
  const int tid = tidx();
  const int b = (mt * 256) >> 13;
  const int row0 = tid >> 4, c8 = tid & 15;
  const float* gp = p.ada + b * 6144 + 2048 + nt * 128 + c8 * 8;
  const float4 g0 = *(const float4*)gp, g1 = *(const float4*)(gp + 4);
#pragma unroll
  for (int half = 0; half < 2; ++half) {
    const float* xp = p.x + (size_t)(mt * 256 + half * 128 + row0) * 1024 + nt * 128 + c8 * 8;
    u16* op = p.x1b + (size_t)(mt * 256 + half * 128 + row0) * 1024 + nt * 128 + c8 * 8;
    float4 xa0 = *(const float4*)xp, xb0 = *(const float4*)(xp + 4);
    float4 xa1 = *(const float4*)(xp + 32 * 1024), xb1 = *(const float4*)(xp + 32 * 1024 + 4);
    stage_acc256(smem, acc, half);
    const float4 xa2 = *(const float4*)(xp + 64 * 1024), xb2 = *(const float4*)(xp + 64 * 1024 + 4);
    const float4 xa3 = *(const float4*)(xp + 96 * 1024), xb3 = *(const float4*)(xp + 96 * 1024 + 4);
#define P5_OUT(I, XA, XB) {                                                                                         \
      const float4 a0 = *(const float4*)(sO + (row0 + 32 * I) * 132 + c8 * 8);                                       \
      const float4 a1 = *(const float4*)(sO + (row0 + 32 * I) * 132 + c8 * 8 + 4);                                   \
      *(uint4*)(op + (size_t)(32 * I) * 1024) =                                                                      \
          make_uint4(pack2(XA.x + g0.x * a0.x, XA.y + g0.y * a0.y), pack2(XA.z + g0.z * a0.z, XA.w + g0.w * a0.w),    \
                     pack2(XB.x + g1.x * a1.x, XB.y + g1.y * a1.y), pack2(XB.z + g1.z * a1.z, XB.w + g1.w * a1.w)); }
    P5_OUT(0, xa0, xb0) P5_OUT(1, xa1, xb1) P5_OUT(2, xa2, xb2) P5_OUT(3, xa3, xb3)
#undef P5_OUT
    __syncthreads();
  }
}

constexpr int P3_WOFF = 71008;
DEV void p3_stage_head(const Params& p, int h, char* smem) {
  float* sWt = (float*)(smem + P3_WOFF);
  const int tid = tidx();
  __syncthreads();
  for (int e = tid; e < 9 * 64; e += NT) {
    const int r = e >> 6, c = e & 63;
    float v;
    if (r < 3) v = p.conv_a_w[r * 512 + h * 64 + c];
    else if (r < 7) v = p.conv_b_w[(r - 3) * 512 + h * 64 + c];
    else if (r == 7) v = p.conv_b_b[h * 64 + c];
    else v = p.gn_a[h * 64 + c];
    sWt[e] = v;
  }
  __syncthreads();
}
DEV void p3_mixer1(const Params& p, int item, char* smem) {
  const int tid = tidx(), lane = tid & 63, w = tid >> 6;
  const int tile = item >> 3, h = item & 7;
  const int t0 = tile * 128;
  const int tb = t0 & 8191;
  const float* sWt = (const float*)(smem + P3_WOFF);
  const uint4 ld_gb0 = *(const uint4*)(p.z + ((size_t)t0 + (tid >> 2)) * 2560 + h * 64 + (tid & 3) * 16);
  const uint4 ld_gb1 = *(const uint4*)(p.z + ((size_t)t0 + (tid >> 2)) * 2560 + h * 64 + (tid & 3) * 16 + 8);
  const int hc_e = h * 64 + (w & 1) * 32 + (lane & 31);
  const float ld_br = p.b_r[hc_e], ld_bi = p.b_i[hc_e], ld_lam = p.lam[hc_e];
  float* sXr = (float*)smem;
  float* sCx = (float*)(smem + 131 * 68 * 4);
  for (int q = tid; q < 131 * 8; q += NT) {
    const int r = q >> 3, c8 = q & 7;
    float f[8];
    if (tb + r - 3 >= 0) {
      const uint4 v = *(const uint4*)(p.z + (size_t)(t0 + r - 3) * 2560 + 1536 + h * 64 + c8 * 8);
      unpack8(v, f);
    } else {
#pragma unroll
      for (int j = 0; j < 8; ++j) f[j] = 0.f;
    }
    *(float4*)(sXr + r * 68 + c8 * 8) = make_float4(f[0], f[1], f[2], f[3]);
    *(float4*)(sXr + r * 68 + c8 * 8 + 4) = make_float4(f[4], f[5], f[6], f[7]);
  }
  for (int q = tid; q < 130 * 8; q += NT) {
    const int r = q >> 3, c8 = q & 7;
    float f[8], g[8];
    if (tb + r - 2 >= 0) {
      const u16* zr = p.z + (size_t)(t0 + r - 2) * 2560 + h * 64 + c8 * 8;
      const uint4 v = *(const uint4*)(zr + 512);
      const uint4 v2 = *(const uint4*)(zr + 1024);
      unpack8(v, f); unpack8(v2, g);
#pragma unroll
      for (int j = 0; j < 8; ++j) f[j] *= g[j];
    } else {
#pragma unroll
      for (int j = 0; j < 8; ++j) f[j] = 0.f;
    }
    *(float4*)(sCx + r * 68 + c8 * 8) = make_float4(f[0], f[1], f[2], f[3]);
    *(float4*)(sCx + r * 68 + c8 * 8 + 4) = make_float4(f[4], f[5], f[6], f[7]);
  }
  __syncthreads();
  const int tl = tid >> 2, q4 = tid & 3;
  const size_t t = (size_t)t0 + tl;
  const int cb = h * 64 + q4 * 16;
  {
    float gb[16], ya[16];
    unpack8(ld_gb0, gb);
    unpack8(ld_gb1, gb + 8);
    float ss = 0.f;
#pragma unroll
    for (int c4 = 0; c4 < 4; ++c4) {
      const float4 w0 = *(const float4*)(sWt + 0 * 64 + q4 * 16 + c4 * 4);
      const float4 w1 = *(const float4*)(sWt + 1 * 64 + q4 * 16 + c4 * 4);
      const float4 w2 = *(const float4*)(sWt + 2 * 64 + q4 * 16 + c4 * 4);
      const float4 x0 = *(const float4*)(sCx + (tl + 0) * 68 + q4 * 16 + c4 * 4);
      const float4 x1 = *(const float4*)(sCx + (tl + 1) * 68 + q4 * 16 + c4 * 4);
      const float4 x2 = *(const float4*)(sCx + (tl + 2) * 68 + q4 * 16 + c4 * 4);
      ya[c4 * 4 + 0] = gb[c4 * 4 + 0] * (w0.x * x0.x + w1.x * x1.x + w2.x * x2.x);
      ya[c4 * 4 + 1] = gb[c4 * 4 + 1] * (w0.y * x0.y + w1.y * x1.y + w2.y * x2.y);
      ya[c4 * 4 + 2] = gb[c4 * 4 + 2] * (w0.z * x0.z + w1.z * x1.z + w2.z * x2.z);
      ya[c4 * 4 + 3] = gb[c4 * 4 + 3] * (w0.w * x0.w + w1.w * x1.w + w2.w * x2.w);
      asm volatile("" ::: "memory");
    }
#pragma unroll
    for (int c = 0; c < 16; ++c) ss += ya[c] * ya[c];
    ss += __shfl_xor(ss, 1, 64);
    ss += __shfl_xor(ss, 2, 64);
    const float rstd = rsqrtf(ss * (1.f / 64.f) + 1e-6f);
    unsigned o[8];
#pragma unroll
    for (int c2 = 0; c2 < 8; ++c2)
      o[c2] = pack2(ya[c2 * 2] * rstd * sWt[8 * 64 + q4 * 16 + c2 * 2], ya[c2 * 2 + 1] * rstd * sWt[8 * 64 + q4 * 16 + c2 * 2 + 1]);
    *(uint4*)(p.ycat + t * 1024 + cb) = make_uint4(o[0], o[1], o[2], o[3]);
    *(uint4*)(p.ycat + t * 1024 + cb + 8) = make_uint4(o[4], o[5], o[6], o[7]);
  }
  unsigned xp[8];
#pragma unroll
  for (int c4 = 0; c4 < 4; ++c4) {
    const float4 w0 = *(const float4*)(sWt + 3 * 64 + q4 * 16 + c4 * 4);
    const float4 w1 = *(const float4*)(sWt + 4 * 64 + q4 * 16 + c4 * 4);
    const float4 w2 = *(const float4*)(sWt + 5 * 64 + q4 * 16 + c4 * 4);
    const float4 w3 = *(const float4*)(sWt + 6 * 64 + q4 * 16 + c4 * 4);
    const float4 bb = *(const float4*)(sWt + 7 * 64 + q4 * 16 + c4 * 4);
    const float4 x0 = *(const float4*)(sXr + (tl + 0) * 68 + q4 * 16 + c4 * 4);
    const float4 x1 = *(const float4*)(sXr + (tl + 1) * 68 + q4 * 16 + c4 * 4);
    const float4 x2 = *(const float4*)(sXr + (tl + 2) * 68 + q4 * 16 + c4 * 4);
    const float4 x3 = *(const float4*)(sXr + (tl + 3) * 68 + q4 * 16 + c4 * 4);
    const float vx = w0.x * x0.x + w1.x * x1.x + w2.x * x2.x + w3.x * x3.x + bb.x;
    const float vy = w0.y * x0.y + w1.y * x1.y + w2.y * x2.y + w3.y * x3.y + bb.y;
    const float vz = w0.z * x0.z + w1.z * x1.z + w2.z * x2.z + w3.z * x3.z + bb.z;
    const float vw = w0.w * x0.w + w1.w * x1.w + w2.w * x2.w + w3.w * x3.w + bb.w;
    xp[c4 * 2] = pack2(vx, vy); xp[c4 * 2 + 1] = pack2(vz, vw);
    asm volatile("" ::: "memory");
  }
  __syncthreads();
  u16* sXp = (u16*)smem;
  *(uint4*)(smem + tl * 144 + q4 * 32) = make_uint4(xp[0], xp[1], xp[2], xp[3]);
  *(uint4*)(smem + tl * 144 + q4 * 32 + 16) = make_uint4(xp[4], xp[5], xp[6], xp[7]);
  __syncthreads();
  const int mt = w >> 1, nt = w & 1;
  f32x16 accR = zero16(), accI = zero16();
#pragma unroll
  for (int kk = 0; kk < 4; ++kk) {
    const bf16x8 a = *(const bf16x8*)(smem + (mt * 32 + (lane & 31)) * 144 + kk * 32 + (lane >> 5) * 16);
    const size_t fo = (size_t)((((h * 2 + nt) * 4 + kk) * 64 + lane)) * 8;
    const bf16x8 br = *(const bf16x8*)(p.WrF + fo);
    const bf16x8 bi = *(const bf16x8*)(p.WiF + fo);
    accR = mfma32(a, br, accR);
    accI = mfma32(a, bi, accI);
  }
  const int j = nt * 32 + (lane & 31);
  const int hc = h * 64 + j;
  float xv[16];
#pragma unroll
  for (int r = 0; r < 16; ++r) xv[r] = bf2f(sXp[(mt * 32 + crow(r, lane)) * 72 + j]);
  __syncthreads();
  float* sLa = (float*)smem;
  float* sU = (float*)(smem + 32768);
  {
    const float br_ = ld_br, bi_ = ld_bi;
    const float sp = log1pf(expf(-ld_lam));
#pragma unroll
    for (int r = 0; r < 16; ++r) {
      const int tl2 = mt * 32 + crow(r, lane);
      const float rr = sigm(accR[r] + br_);
      const float ii = sigm(accI[r] + bi_);
      const float la = -8.f * rr * sp;
      const float u = sqrtf(-expm1f(2.f * la)) * ii * xv[r];
      sLa[tl2 * 64 + j] = la;
      sU[tl2 * 64 + j] = u;
      asm volatile("" ::: "memory");
    }
  }
  __syncthreads();
  const int seg = tid >> 6, ch = tid & 63;
  float* sSegA = (float*)(smem + 65536);
  float* sSegH = sSegA + 512;
  {
    float cum = 0.f, hh = 0.f;
#pragma unroll 4
    for (int i = 0; i < 16; ++i) {
      const int ix = (seg * 16 + i) * 64 + ch;
      const float la = sLa[ix], u = sU[ix];
      hh = __expf(la) * hh + u;
      cum += la;
      sU[ix] = hh; sLa[ix] = cum;
    }
    sSegA[seg * 64 + ch] = cum; sSegH[seg * 64 + ch] = hh;
  }
  __syncthreads();
  {
    float cH = 0.f, cL = 0.f;
#pragma unroll
    for (int s2 = 0; s2 < 7; ++s2) {
      if (s2 < seg) {
        const float A = sSegA[s2 * 64 + ch];
        cH = __expf(A) * cH + sSegH[s2 * 64 + ch];
        cL += A;
      }
    }
#pragma unroll 2
    for (int i = 0; i < 16; ++i) {
      const int ix = (seg * 16 + i) * 64 + ch;
      const float cs = sLa[ix];
      const float lp = cs + cL;
      const float hl = sU[ix] + __expf(cs) * cH;
      const size_t go = (size_t)(t0 + seg * 16 + i) * 512 + h * 64 + ch;
      p.hloc[go] = f2bf(hl);
      p.logP[go] = f2bf(lp);
      if (seg == 7 && i == 15) {
        p.Hend[tile * 512 + h * 64 + ch] = hl;
        p.Pend[tile * 512 + h * 64 + ch] = lp;
      }
    }
  }
  __syncthreads();
}

DEV void p4_mixer2(const Params& p, int item, char* smem) {
  const int tid = tidx();
  const int tile = item >> 3, h = item & 7;
  const int t0 = tile * 128;
  const int b = tile >> 6, cidx = tile & 63;
  float* sSegA = (float*)smem;
  float* sSegH = sSegA + 512;
  float* sCarry = sSegH + 512;
  const int seg = tid >> 6, ch = tid & 63;
  const int tl = tid >> 2, q4 = tid & 3;
  const size_t t = (size_t)t0 + tl;
  const int cb = h * 64 + q4 * 16;
  const uint4 ld_h0 = *(const uint4*)(p.hloc + t * 512 + cb), ld_h1 = *(const uint4*)(p.hloc + t * 512 + cb + 8);
  const uint4 ld_p0 = *(const uint4*)(p.logP + t * 512 + cb), ld_p1 = *(const uint4*)(p.logP + t * 512 + cb + 8);
  const uint4 ld_g0 = *(const uint4*)(p.z + t * 2560 + 2048 + cb), ld_g1 = *(const uint4*)(p.z + t * 2560 + 2048 + cb + 8);
  {
    float A = 0.f, H = 0.f;
#pragma unroll
    for (int i = 0; i < 8; ++i) {
      const int c2 = seg * 8 + i;
      if (c2 < cidx) {
        const size_t o = (size_t)(b * 64 + c2) * 512 + h * 64 + ch;
        const float pl = p.Pend[o];
        H = __expf(pl) * H + p.Hend[o];
        A += pl;
      }
    }
    sSegA[seg * 64 + ch] = A; sSegH[seg * 64 + ch] = H;
  }
  __syncthreads();
  if (tid < 64) {
    float cH = 0.f;
#pragma unroll
    for (int s2 = 0; s2 < 8; ++s2) cH = __expf(sSegA[s2 * 64 + ch]) * cH + sSegH[s2 * 64 + ch];
    sCarry[ch] = cH;
  }
  __syncthreads();
  float hl[16], lp[16], gr[16], yb[16];
  unpack8(ld_h0, hl); unpack8(ld_h1, hl + 8);
  unpack8(ld_p0, lp); unpack8(ld_p1, lp + 8);
  unpack8(ld_g0, gr); unpack8(ld_g1, gr + 8);
  float ss = 0.f;
#pragma unroll
  for (int c = 0; c < 16; ++c) {
    const float hv = hl[c] + __expf(lp[c]) * sCarry[q4 * 16 + c];
    yb[c] = hv * gelu_tanh(gr[c]);
    ss += yb[c] * yb[c];
  }
  ss += __shfl_xor(ss, 1, 64);
  ss += __shfl_xor(ss, 2, 64);
  const float rstd = rsqrtf(ss * (1.f / 64.f) + 1e-6f);
  unsigned o[8];
#pragma unroll
  for (int c2 = 0; c2 < 8; ++c2)
    o[c2] = pack2(yb[c2 * 2] * rstd * p.gn_b[cb + c2 * 2], yb[c2 * 2 + 1] * rstd * p.gn_b[cb + c2 * 2 + 1]);
  *(uint4*)(p.ycat + t * 1024 + 512 + cb) = make_uint4(o[0], o[1], o[2], o[3]);
  *(uint4*)(p.ycat + t * 1024 + 512 + cb + 8) = make_uint4(o[4], o[5], o[6], o[7]);
  __syncthreads();
}

__constant__ unsigned FTAB[16] = {0x03020100u, 0x07060504u, 0x0B0A0908u, 0x0F0E0D0Cu, 0x13121110u, 0x17161514u, 0x23222120u, 0x33323130u,
                                  0x24424140u, 0x61605150u, 0x90807170u, 0xD0C0B0A0u, 0xFFFFF0E0u, 0xFFFFFFFFu, 0xFFFFFFFFu, 0xFFFFFFFFu};
DEV void p7_route(const Params& p, int item, char* smem) {
  const int tid = tidx(), lane = tid & 63, w = tid >> 6;
  const int mt = item >> 3, hh = item & 7;
  const int m0 = mt * 128;
  const int rg = lane >> 4, li = lane & 15;
  bf16x8 bkf[4];
#pragma unroll
  for (int kk = 0; kk < 4; ++kk)
    bkf[kk] = *(const bf16x8*)(p.keysF + (size_t)(((((hh * 2 + (w >> 2)) * 4 + (w & 3)) * 4 + kk) * 64 + lane)) * 8);
  const unsigned tabw = FTAB[li];
  f32x16 acc0 = zero16(), acc1 = zero16();
  gemm_core(p.h, p.WqT, m0, hh * 128, smem, acc0, acc1);
  u16* sQ = (u16*)smem;
  float* sS = (float*)(smem + 34816);
  unsigned* sTop = (unsigned*)(smem + 34816 + 33792);
  {
    const int wr = w >> 1, wc = w & 1;
#pragma unroll
    for (int r = 0; r < 16; ++r) {
      const int row = wr * 32 + crow(r, lane);
      sQ[row * 136 + wc * 64 + (lane & 31)] = f2bf(acc0[r]);
      sQ[row * 136 + wc * 64 + 32 + (lane & 31)] = f2bf(acc1[r]);
    }
  }
  __syncthreads();
#pragma unroll 1
  for (int chunk = 0; chunk < 4; ++chunk) {
    {
      const int c = w >> 2, nt = w & 3;
      f32x16 s = zero16();
#pragma unroll
      for (int kk = 0; kk < 4; ++kk) {
        const bf16x8 a = *(const bf16x8*)(smem + (chunk * 32 + (lane & 31)) * 272 +
                                          (c * 64 + kk * 16 + (lane >> 5) * 8) * 2);
        s = mfma32(a, bkf[kk], s);
      }
#pragma unroll
      for (int r = 0; r < 16; ++r) sS[(c * 32 + crow(r, lane)) * 132 + nt * 32 + (lane & 31)] = s[r];
    }
    __syncthreads();
    const int tokl = w * 4 + rg;
    unsigned res[2];
#pragma unroll
    for (int c = 0; c < 2; ++c) {
      unsigned k[8];
#pragma unroll
      for (int jj = 0; jj < 8; ++jj) {
        const float v = sS[(c * 32 + tokl) * 132 + li + 16 * jj];
        k[jj] = (sortable(v) & ~127u) | (unsigned)(li + 16 * jj);
      }
#define CE_(i, j) { const unsigned hi_ = max(k[i], k[j]), lo_ = min(k[i], k[j]); k[i] = hi_; k[j] = lo_; }
      CE_(0, 1) CE_(2, 3) CE_(4, 5) CE_(6, 7) CE_(0, 2) CE_(1, 3) CE_(4, 6) CE_(5, 7) CE_(1, 2) CE_(5, 6)
      CE_(0, 4) CE_(1, 5) CE_(2, 6) CE_(3, 7) CE_(2, 4) CE_(3, 5) CE_(1, 2) CE_(3, 4) CE_(5, 6)
#undef CE_
      unsigned r_ = 0;
#pragma unroll
      for (int it = 0; it < 16; ++it) {
        const unsigned m = row_max_u(k[0]);
        const bool win = (k[0] == m);
        r_ = (li == it) ? m : r_;
#pragma unroll
        for (int jj = 0; jj < 7; ++jj) k[jj] = win ? k[jj + 1] : k[jj];
        k[7] = win ? 0u : k[7];
      }
      res[c] = r_;
    }
    unsigned* tp = sTop + (w * 4 + rg) * 32;
    tp[li] = res[0];
    tp[16 + li] = res[1];
    __syncthreads();
    {
      unsigned ck[4];
#pragma unroll
      for (int j = 0; j < 4; ++j) {
        const unsigned code = (tabw >> (8 * j)) & 0xFFu;
        const float s0 = unsortable(tp[code >> 4] & ~127u);
        const float s1 = unsortable(tp[16 + (code & 15u)] & ~127u);
        const unsigned key = (sortable(s0 + s1) & ~255u) | code;
        ck[j] = (code == 0xFFu) ? 0u : key;
      }
#define CE4_(i, j) { const unsigned hi_ = max(ck[i], ck[j]), lo_ = min(ck[i], ck[j]); ck[i] = hi_; ck[j] = lo_; }
      CE4_(0, 1) CE4_(2, 3) CE4_(0, 2) CE4_(1, 3) CE4_(1, 2)
#undef CE4_
      unsigned r_ = 0;
#pragma unroll
      for (int it = 0; it < 16; ++it) {
        const unsigned m = row_max_u(ck[0]);
        const bool win = (ck[0] == m);
        r_ = (li == it) ? m : r_;
        ck[0] = win ? ck[1] : ck[0];
        ck[1] = win ? ck[2] : ck[1];
        ck[2] = win ? ck[3] : ck[2];
        ck[3] = win ? 0u : ck[3];
      }
      const int pos = r_ & 255;
      const int i0 = tp[pos >> 4] & 127, i1 = tp[16 + (pos & 15)] & 127;
      const float bs = unsortable(r_ & ~255u);
      const float mx = unsortable(row_max_u(r_) & ~255u);
      const float e = __expf(bs - mx);
      const float sum = row_sum_f(e);
      const size_t tg = (size_t)m0 + chunk * 32 + tokl;
      p.idx16[tg * 128 + hh * 16 + li] = (unsigned short)(i0 * 128 + i1);
      p.gsel[tg * 128 + hh * 16 + li] = e / sum;
    }
    __syncthreads();
  }
}

DEV void unpack_fp8x16(uint4 v, float* f) {
  typedef float f2_t __attribute__((ext_vector_type(2)));
  f2_t r;
  r = __builtin_amdgcn_cvt_pk_f32_fp8((int)v.x, false); f[0] = r.x; f[1] = r.y;
  r = __builtin_amdgcn_cvt_pk_f32_fp8((int)v.x, true);  f[2] = r.x; f[3] = r.y;
  r = __builtin_amdgcn_cvt_pk_f32_fp8((int)v.y, false); f[4] = r.x; f[5] = r.y;
  r = __builtin_amdgcn_cvt_pk_f32_fp8((int)v.y, true);  f[6] = r.x; f[7] = r.y;
  r = __builtin_amdgcn_cvt_pk_f32_fp8((int)v.z, false); f[8] = r.x; f[9] = r.y;
  r = __builtin_amdgcn_cvt_pk_f32_fp8((int)v.z, true);  f[10] = r.x; f[11] = r.y;
  r = __builtin_amdgcn_cvt_pk_f32_fp8((int)v.w, false); f[12] = r.x; f[13] = r.y;
  r = __builtin_amdgcn_cvt_pk_f32_fp8((int)v.w, true);  f[14] = r.x; f[15] = r.y;
}
typedef _Float16 h2_t __attribute__((ext_vector_type(2)));
DEV unsigned packh2(float a, float b) {
  h2_t v; v.x = (_Float16)a; v.y = (_Float16)b;
  return __builtin_bit_cast(unsigned, v);
}
DEV float sum8_f(float v) {
  v += __uint_as_float(dpp_u<0xB1>(__float_as_uint(v)));
  v += __uint_as_float(dpp_u<0x4E>(__float_as_uint(v)));
  v += __uint_as_float(dpp_u<0x141>(__float_as_uint(v)));
  return v;
}
DEV unsigned id_of(const unsigned* w, int i) { return (i & 1) ? (w[i >> 1] >> 16) : (w[i >> 1] & 0xFFFFu); }
DEV float half_of(const unsigned* w, int i) {
  const unsigned short b = (i & 1) ? (unsigned short)(w[i >> 1] >> 16) : (unsigned short)(w[i >> 1] & 0xFFFFu);
  return (float)__builtin_bit_cast(_Float16, b);
}
DEV void p8_udots_all(const Params& p) {
  const int tid = tidx(), lane = tid & 63, w = tid >> 6;
  const int es = lane >> 3, cl = lane & 7;
  const unsigned lo = cl * 16;
  const int n = 65536;
  int v = blockIdx.x;
  if (v >= n) return;
  unsigned idw[8];
  uint4 hq, rA[8];
  {
    const size_t t = (size_t)(v >> 3) * 8 + w;
    const uint4 i0 = *(const uint4*)(p.idx16 + t * 128 + es * 16);
    const uint4 i1 = *(const uint4*)(p.idx16 + t * 128 + es * 16 + 8);
    hq = *(const uint4*)(p.h8 + t * 1024 + (v & 7) * 128 + cl * 16);
    idw[0] = i0.x; idw[1] = i0.y; idw[2] = i0.z; idw[3] = i0.w; idw[4] = i1.x; idw[5] = i1.y; idw[6] = i1.z; idw[7] = i1.w;
    const unsigned char* ub0 = p.Ub + (size_t)(v & 7) * (16384 * 128);
#pragma unroll
    for (int i = 0; i < 8; ++i) rA[i] = *(const uint4*)(ub0 + (id_of(idw, i) * 128u + lo));
  }
#define U_ROW(RW, OUT)                                                                     \
  {                                                                                        \
    int isum = __builtin_amdgcn_sdot4((int)(RW).x, (int)hcur.x, 0, false);                 \
    isum = __builtin_amdgcn_sdot4((int)(RW).y, (int)hcur.y, isum, false);                  \
    isum = __builtin_amdgcn_sdot4((int)(RW).z, (int)hcur.z, isum, false);                  \
    isum = __builtin_amdgcn_sdot4((int)(RW).w, (int)hcur.w, isum, false);                  \
    unsigned us = (unsigned)isum;                                                          \
    us += dpp_u<0xB1>(us); us += dpp_u<0x4E>(us); us += dpp_u<0x141>(us);                  \
    asm volatile("" : "+v"(us));                                                           \
    OUT = (float)(int)us * (1.f / 256.f);                                                  \
    __builtin_amdgcn_sched_barrier(0);                                                     \
  }
#pragma unroll 1
  for (; v < n; v += gridDim.x) {
    const int x = v & 7;
    const size_t t = (size_t)(v >> 3) * 8 + w;
    const uint4 hcur = hq;
    const unsigned char* ub = p.Ub + (size_t)x * (16384 * 128);
    uint4 rB[8];
#pragma unroll
    for (int i = 0; i < 8; ++i) rB[i] = *(const uint4*)(ub + (id_of(idw, 8 + i) * 128u + lo));
    {
      const int vn = min(v + (int)gridDim.x, n - 8 + x);
      const size_t tn = (size_t)(vn >> 3) * 8 + w;
      const uint4 n0 = *(const uint4*)(p.idx16 + tn * 128 + es * 16);
      const uint4 n1 = *(const uint4*)(p.idx16 + tn * 128 + es * 16 + 8);
      hq = *(const uint4*)(p.h8 + tn * 1024 + x * 128 + cl * 16);
      idw[0] = n0.x; idw[1] = n0.y; idw[2] = n0.z; idw[3] = n0.w; idw[4] = n1.x; idw[5] = n1.y; idw[6] = n1.z; idw[7] = n1.w;
    }
    __builtin_amdgcn_sched_barrier(0);
    unsigned dp[8];
#pragma unroll
    for (int i2 = 0; i2 < 4; ++i2) {
      float d0, d1;
      U_ROW(rA[i2 * 2], d0)
      U_ROW(rA[i2 * 2 + 1], d1)
      dp[i2] = packh2(d0, d1);
    }
#pragma unroll
    for (int i = 0; i < 8; ++i) rA[i] = *(const uint4*)(ub + (id_of(idw, i) * 128u + lo));
    __builtin_amdgcn_sched_barrier(0);
#pragma unroll
    for (int i2 = 0; i2 < 4; ++i2) {
      float d0, d1;
      U_ROW(rB[i2 * 2], d0)
      U_ROW(rB[i2 * 2 + 1], d1)
      dp[4 + i2] = packh2(d0, d1);
    }
    if (cl == 0) {
      unsigned short* pp = p.Pd + (t * 8 + (size_t)x) * 128 + es * 16;
      *(uint4*)pp = make_uint4(dp[0], dp[1], dp[2], dp[3]);
      *(uint4*)(pp + 8) = make_uint4(dp[4], dp[5], dp[6], dp[7]);
    }
  }
#undef U_ROW
}
DEV void p8_coef(const Params& p, int item) {
  const int tid = tidx(), lane = tid & 63, w = tid >> 6;
  const size_t t0 = (size_t)item * 32 + w * 4;
  float s0[4], s1[4];
  unsigned iw[4];
  float2 gv[4];
#pragma unroll
  for (int k = 0; k < 4; ++k) {
    const size_t t = t0 + k;
    s0[k] = 0.f; s1[k] = 0.f;
#pragma unroll
    for (int x = 0; x < 8; ++x) {
      const unsigned pv = *(const unsigned*)(p.Pd + (t * 8 + (size_t)x) * 128 + lane * 2);
      s0[k] += half_of(&pv, 0); s1[k] += half_of(&pv, 1);
    }
    iw[k] = *(const unsigned*)(p.idx16 + t * 128 + lane * 2);
    gv[k] = *(const float2*)(p.gsel + t * 128 + lane * 2);
  }
#pragma unroll
  for (int k = 0; k < 4; ++k) {
    const size_t t = t0 + k;
    const unsigned ia = iw[k] & 0xFFFFu, ib = iw[k] >> 16;
    const float hs = 256.f * p.hS[t];
    const float d0 = s0[k] * p.uS[ia] * hs, d1 = s1[k] * p.uS[ib] * hs;
    const float a0 = 0.5f * d0 * (1.f + erff(d0 * 0.7071067811865476f));
    const float a1 = 0.5f * d1 * (1.f + erff(d1 * 0.7071067811865476f));
    *(unsigned*)(p.coef16 + t * 128 + lane * 2) = packh2(1024.f * gv[k].x * a0 * p.vS[ia], 1024.f * gv[k].y * a1 * p.vS[ib]);
  }
}
DEV void p8_vacc_all(const Params& p, char* smem) {
  const int tid = tidx(), lane = tid & 63, w = tid >> 6;
  const int es = lane >> 3, cl = lane & 7;
  const unsigned lo = cl * 16;
  const int n = 65536;
  int v = blockIdx.x;
  if (v >= n) return;
  unsigned idw[8];
  uint4 rA[8];
  {
    const size_t t = (size_t)(v >> 3) * 8 + w;
    const uint4 i0 = *(const uint4*)(p.idx16 + t * 128 + es * 16);
    const uint4 i1 = *(const uint4*)(p.idx16 + t * 128 + es * 16 + 8);
    idw[0] = i0.x; idw[1] = i0.y; idw[2] = i0.z; idw[3] = i0.w; idw[4] = i1.x; idw[5] = i1.y; idw[6] = i1.z; idw[7] = i1.w;
    const unsigned char* vb0 = p.Vb + (size_t)(v & 7) * (16384 * 128);
#pragma unroll
    for (int i = 0; i < 8; ++i) rA[i] = *(const uint4*)(vb0 + (id_of(idw, i) * 128u + lo));
  }
#define V_CONSUME(RW, I)                                                                                   \
  {                                                                                                        \
    const h2_t cpair = __builtin_bit_cast(h2_t, cw[(I) >> 1]);                                             \
    h2_t cf2;                                                                                              \
    cf2.x = ((I) & 1) ? cpair.y : cpair.x; cf2.y = cf2.x;                                                  \
    const unsigned wds[4] = {(RW).x, (RW).y, (RW).z, (RW).w};                                              \
    _Pragma("unroll") for (int d4 = 0; d4 < 4; ++d4) {                                                     \
      const h2_t v0 = __builtin_amdgcn_cvt_scalef32_pk_f16_fp8(wds[d4], 1.0f, false);                      \
      const h2_t v1 = __builtin_amdgcn_cvt_scalef32_pk_f16_fp8(wds[d4], 1.0f, true);                       \
      acc2[d4 * 2] = cf2 * v0 + acc2[d4 * 2];                                                              \
      acc2[d4 * 2 + 1] = cf2 * v1 + acc2[d4 * 2 + 1];                                                      \
    }                                                                                                      \
    asm volatile("" : "+v"(acc2[0]), "+v"(acc2[1]), "+v"(acc2[2]), "+v"(acc2[3]), "+v"(acc2[4]), "+v"(acc2[5]), "+v"(acc2[6]), "+v"(acc2[7])); \
    __builtin_amdgcn_sched_barrier(0);                                                                     \
  }
#pragma unroll 1
  for (; v < n; v += gridDim.x) {
    const int x = v & 7;
    const size_t t = (size_t)(v >> 3) * 8 + w;
    const uint4 c0 = *(const uint4*)(p.coef16 + t * 128 + es * 16);
    const uint4 c1 = *(const uint4*)(p.coef16 + t * 128 + es * 16 + 8);
    const unsigned cw[8] = {c0.x, c0.y, c0.z, c0.w, c1.x, c1.y, c1.z, c1.w};
    const unsigned char* vb = p.Vb + (size_t)x * (16384 * 128);
    uint4 rB[8];
#pragma unroll
    for (int i = 0; i < 8; ++i) rB[i] = *(const uint4*)(vb + (id_of(idw, 8 + i) * 128u + lo));
    const int vn = min(v + (int)gridDim.x, n - 8 + x);
    const size_t tn = (size_t)(vn >> 3) * 8 + w;
    {
      const uint4 n0 = *(const uint4*)(p.idx16 + tn * 128 + es * 16);
      const uint4 n1 = *(const uint4*)(p.idx16 + tn * 128 + es * 16 + 8);
      idw[0] = n0.x; idw[1] = n0.y; idw[2] = n0.z; idw[3] = n0.w; idw[4] = n1.x; idw[5] = n1.y; idw[6] = n1.z; idw[7] = n1.w;
    }
    __builtin_amdgcn_sched_barrier(0);
    h2_t acc2[8];
#pragma unroll
    for (int j = 0; j < 8; ++j) { acc2[j].x = (_Float16)0.f; acc2[j].y = (_Float16)0.f; }
    const int b = (int)(t >> 13);
    const int col = x * 128 + lane * 2;
#pragma unroll
    for (int i = 0; i < 8; ++i) V_CONSUME(rA[i], i)
#pragma unroll
    for (int i = 0; i < 8; ++i) rA[i] = *(const uint4*)(vb + (id_of(idw, i) * 128u + lo));
    __builtin_amdgcn_sched_barrier(0);
#pragma unroll
    for (int i = 0; i < 8; ++i) V_CONSUME(rB[i], 8 + i)
    const float2 gv = *(const float2*)(p.ada + b * 6144 + 5120 + col);
    const unsigned xw = *(const unsigned*)(p.x1b + t * 1024 + col);
    unsigned* sWh = (unsigned*)smem + w * (8 * 68);
    *(uint4*)(sWh + es * 68 + cl * 8) = make_uint4(__builtin_bit_cast(unsigned, acc2[0]), __builtin_bit_cast(unsigned, acc2[1]),
                                                   __builtin_bit_cast(unsigned, acc2[2]), __builtin_bit_cast(unsigned, acc2[3]));
    *(uint4*)(sWh + es * 68 + cl * 8 + 4) = make_uint4(__builtin_bit_cast(unsigned, acc2[4]), __builtin_bit_cast(unsigned, acc2[5]),
                                                       __builtin_bit_cast(unsigned, acc2[6]), __builtin_bit_cast(unsigned, acc2[7]));
    __builtin_amdgcn_fence(__ATOMIC_RELEASE, "wavefront");
    __builtin_amdgcn_wave_barrier();
    __builtin_amdgcn_fence(__ATOMIC_ACQUIRE, "wavefront");
    h2_t hsum = __builtin_bit_cast(h2_t, sWh[lane]);
#pragma unroll
    for (int e2 = 1; e2 < 8; ++e2) hsum = hsum + __builtin_bit_cast(h2_t, sWh[e2 * 68 + lane]);
    const float o0 = (float)hsum.x, o1 = (float)hsum.y;
    __builtin_amdgcn_fence(__ATOMIC_RELEASE, "wavefront");
    __builtin_amdgcn_wave_barrier();
    const float2 xv = make_float2(__uint_as_float(xw << 16), __uint_as_float(xw & 0xFFFF0000u));
    float2 o;
    o.x = xv.x + gv.x * (o0 * (1.f / 1024.f)); o.y = xv.y + gv.y * (o1 * (1.f / 1024.f));
    *(unsigned*)(p.x2b + t * 1024 + col) = pack2(o.x, o.y);
  }
#undef V_CONSUME
}
DEV void p8_final(const Params& p, int item) {
  const int tid = tidx(), lane = tid & 63, w = tid >> 6;
  const size_t t0 = (size_t)item * 32 + w * 4;
  float4 fg[4];
#pragma unroll
  for (int i = 0; i < 4; ++i) fg[i] = *(const float4*)(p.final_g + i * 256 + lane * 4);
  uint2 r2[4][4];
#pragma unroll
  for (int k = 0; k < 4; ++k)
#pragma unroll
    for (int i = 0; i < 4; ++i) r2[k][i] = *(const uint2*)(p.x2b + (t0 + k) * 1024 + i * 256 + lane * 4);
#pragma unroll
  for (int k = 0; k < 4; ++k) {
    const size_t t = t0 + k;
    float xv[16];
    float ss = 0.f;
#pragma unroll
    for (int i = 0; i < 4; ++i) {
      xv[i * 4 + 0] = __uint_as_float(r2[k][i].x << 16); xv[i * 4 + 1] = __uint_as_float(r2[k][i].x & 0xFFFF0000u);
      xv[i * 4 + 2] = __uint_as_float(r2[k][i].y << 16); xv[i * 4 + 3] = __uint_as_float(r2[k][i].y & 0xFFFF0000u);
      ss += xv[i * 4] * xv[i * 4] + xv[i * 4 + 1] * xv[i * 4 + 1] + xv[i * 4 + 2] * xv[i * 4 + 2] + xv[i * 4 + 3] * xv[i * 4 + 3];
    }
    ss = wave_allsum(ss);
    const float r = rsqrtf(ss * (1.f / 1024.f) + 1e-6f);
#pragma unroll
    for (int i = 0; i < 4; ++i)
      *(float4*)(p.out + t * 1024 + i * 256 + lane * 4) =
          make_float4(xv[i * 4] * r * fg[i].x, xv[i * 4 + 1] * r * fg[i].y, xv[i * 4 + 2] * r * fg[i].z, xv[i * 4 + 3] * r * fg[i].w);
  }
}

#define XB_TMO      128
#define XB_XCNT(j)  (256  + 64 * (j))
#define XB_XSUB(j)  (1280 + 64 * (j))
#define XB_XGEN(j)  (2304 + 64 * (j))
#define XB_TOP      3328
#define XB_TOPGEN   3392
#define XCD_BAR_WORDS 3456
#define XB_SPIN_CAP (1u << 22)
#define LAS __attribute__((address_space(3)))
DEV unsigned xb_ld(unsigned* p)              { return __hip_atomic_load(p, __ATOMIC_RELAXED, __HIP_MEMORY_SCOPE_AGENT); }
DEV unsigned xb_add(unsigned* p, unsigned v) { return __hip_atomic_fetch_add(p, v, __ATOMIC_RELAXED, __HIP_MEMORY_SCOPE_AGENT); }
DEV unsigned xb_xcc_id() { return (unsigned)__builtin_amdgcn_s_getreg((3 << 11) | 20) & 0xFu; }
#define XB_SPIN(cond, bar) do { unsigned _sp = 0; while (cond) { __builtin_amdgcn_s_sleep(1); \
    if ((++_sp & 255u) == 0u) { if (xb_ld(&(bar)[XB_TMO])) break; if (_sp > XB_SPIN_CAP) { atomicAdd(&(bar)[XB_TMO], 1u); break; } } } } while (0)
struct XcdBarrier { unsigned* bar; unsigned x; volatile LAS unsigned* st; };
DEV XcdBarrier xcd_barrier_post(unsigned* bar, volatile LAS unsigned* st) {
  XcdBarrier b; b.bar = bar; b.x = xb_xcc_id(); b.st = st;
  if (threadIdx.x == 0) (void)xb_add(&bar[XB_XCNT(b.x)], 1u);
  return b;
}
DEV void xcd_barrier_complete(unsigned* bar, unsigned x, unsigned& nloc, unsigned& nx) {
  const unsigned G = gridDim.x * gridDim.y * gridDim.z;
  unsigned sum, cnt, mine, sp = 0u;
  for (;;) {
    sum = 0u; cnt = 0u; mine = 0u;
#pragma unroll
    for (unsigned j = 0; j < 16; ++j) { const unsigned c = xb_ld(&bar[XB_XCNT(j)]); sum += c; cnt += (c > 0u) ? 1u : 0u; mine = (j == x) ? c : mine; }
    if (sum == G) break;
    __builtin_amdgcn_s_sleep(1);
    if ((++sp & 255u) == 0u) { if (xb_ld(&bar[XB_TMO])) break; if (sp > XB_SPIN_CAP) { atomicAdd(&bar[XB_TMO], 1u); break; } }
  }
  nloc = mine > 0u ? mine : 1u; nx = cnt > 0u ? cnt : 1u;
}
DEV void xcd_barrier(const XcdBarrier& b) {
  asm volatile("s_waitcnt vmcnt(0)" ::: "memory");
  __syncthreads();
  if (threadIdx.x == 0) {
    unsigned* bar = b.bar;
    __builtin_amdgcn_s_waitcnt(0);
    unsigned nloc = b.st[0], nx = b.st[1];
    if (nloc == 0u) { xcd_barrier_complete(bar, b.x, nloc, nx); b.st[0] = nloc; b.st[1] = nx; }
    const unsigned old = xb_add(&bar[XB_XSUB(b.x)], 1u);
    const unsigned gen = old / nloc;
    if (old + 1u == (gen + 1u) * nloc) {
      __builtin_amdgcn_fence(__ATOMIC_RELEASE, "agent");
      asm volatile("s_waitcnt vmcnt(0)" ::: "memory");
      const unsigned og = xb_add(&bar[XB_TOP], 1u);
      const unsigned tg = og / nx;
      if (og + 1u == (tg + 1u) * nx) xb_add(&bar[XB_TOPGEN], 1u);
      else XB_SPIN(xb_ld(&bar[XB_TOPGEN]) == tg, bar);
      __builtin_amdgcn_fence(__ATOMIC_ACQUIRE, "agent");
      xb_add(&bar[XB_XGEN(b.x)], 1u);
      asm volatile("s_waitcnt vmcnt(0)" ::: "memory");
    } else {
      XB_SPIN(xb_ld(&bar[XB_XGEN(b.x)]) == gen, bar);
      __builtin_amdgcn_fence(__ATOMIC_ACQUIRE, "agent");
      asm volatile("s_waitcnt vmcnt(0)" ::: "memory");
    }
  }
  __syncthreads();
}

DEV int xcd_swz(int v, int n) { return (v & 7) * (n >> 3) + (v >> 3); }

template <int PH> DEV void run_phase(const Params& p, char* smem) {
  if (PH == 3) {
    int hcur = -1;
#pragma unroll 1
    for (int v = blockIdx.x; v < 4096; v += gridDim.x) {
      const int h = v & 7;
      if (h != hcur) { p3_stage_head(p, h, smem); hcur = h; }
      p3_mixer1(p, v, smem);
    }
    return;
  }
  if (PH == 2 || PH == 5 || PH == 7) {
    if (blockIdx.x >= (gridDim.x >> 1)) {
#pragma unroll 1
      for (int i_ = 0; i_ < 6; ++i_) __builtin_amdgcn_s_sleep(100);
    }
  }
  if (PH == 8) { p8_udots_all(p); return; }
  if (PH == 10) { p8_vacc_all(p, smem); return; }
  constexpr int n = PH == 0 ? P0_ITEMS : PH == 1 ? 1024 : PH == 2 ? 5120 : PH == 3 ? 4096 : PH == 4 ? 4096
                  : PH == 5 ? 2048 : PH == 6 ? 1024 : PH == 7 ? 4096 : PH == 8 ? 65536 : PH == 9 ? 2048
                  : PH == 10 ? 65536 : 2048;
  for (int v = blockIdx.x; v < n; v += gridDim.x) {
    if (PH == 0) phase0(p, v, smem);
    else if (PH == 1) p_norm_mod<false>(p.x, p.norm1_g, p.ada, 0, 1024, p.h, nullptr, nullptr, v);
    else if (PH == 2) p2_gemm1(p, xcd_swz(v, n), smem);
    else if (PH == 3) p3_mixer1(p, v, smem);
    else if (PH == 4) p4_mixer2(p, v, smem);
    else if (PH == 5) p5_gemm2(p, xcd_swz(v, n), smem);
    else if (PH == 6) p_norm_mod<true>(p.x1b, p.norm2_g, p.ada, 3072, 4096, p.h, p.h8, p.hS, v);
    else if (PH == 7) p7_route(p, xcd_swz(v, n), smem);
    else if (PH == 9) p8_coef(p, v);
    else p8_final(p, v);
  }
}

#if MULTI_LAUNCH
template <int PH> __global__ void __launch_bounds__(NT) k_phase(Params p) {
  extern __shared__ __attribute__((aligned(16))) char smem[];
  run_phase<PH>(p, smem);
}
#else
__global__ void __launch_bounds__(NT, 4) mega(Params p) {
  extern __shared__ __attribute__((aligned(16))) char smem[];
  cg::grid_group grid = cg::this_grid();
  volatile LAS unsigned* xst = (volatile LAS unsigned*)(smem + LDS_PHASE);
  if (threadIdx.x < 2) xst[threadIdx.x] = 0u;
  __syncthreads();
  const XcdBarrier xb = xcd_barrier_post(p.bar, xst);
  if (p.reps < 0) grid.sync();
#ifndef PROBE_PH
#define PROBE_PH -1
#endif
#define RUNPH(K, SYNC)                                                        \
  for (int r_ = 0; r_ < ((PROBE_PH == K) ? p.reps : 1); ++r_) {              \
    run_phase<K>(p, smem);                                                    \
    if (SYNC || PROBE_PH == K) xcd_barrier(xb);                               \
  }
  RUNPH(0, 1) RUNPH(1, 1) RUNPH(2, 1) RUNPH(3, 1) RUNPH(4, 1) RUNPH(5, 1) RUNPH(6, 1) RUNPH(7, 1) RUNPH(8, 1) RUNPH(9, 1) RUNPH(10, 1) RUNPH(11, 0)
}
#endif

extern "C" void kernel_launch(void* const* d_in, const int* in_sizes, int n_in, void* d_out, int out_size,
                              void* d_ws, size_t ws_size, hipStream_t stream) {
  Params p{};
  const float* const* in = (const float* const*)d_in;
  p.x = in[0]; p.c = in[1]; p.w_ada = in[2]; p.b_ada = in[3]; p.norm1_g = in[4]; p.w_in = in[5];
  p.conv_a_w = in[6]; p.conv_b_w = in[7]; p.conv_b_b = in[8]; p.w_r = in[9]; p.b_r = in[10];
  p.w_i = in[11]; p.b_i = in[12]; p.lam = in[13]; p.gn_a = in[14]; p.gn_b = in[15]; p.w_out = in[16];
  p.norm2_g = in[17]; p.w_q = in[18]; p.sub_keys = in[19]; p.expert_u = in[20]; p.expert_v = in[21];
  p.final_g = in[22];
  p.out = (float*)d_out;
  char* ws = (char*)d_ws;
  size_t off = 0;
  auto alloc = [&](size_t bytes) { void* r = ws + off; off += (bytes + 255) & ~(size_t)255; return r; };
  p.ada = (float*)alloc(8 * 6144 * 4);
  p.WinT = (u16*)alloc((size_t)2560 * 1024 * 2);
  p.WoutT = (u16*)alloc((size_t)1024 * 1024 * 2);
  p.WqT = (u16*)alloc((size_t)1024 * 1024 * 2);
  p.keysF = (u16*)alloc(131072 * 2);
  p.WrF = (u16*)alloc(32768 * 2);
  p.WiF = (u16*)alloc(32768 * 2);
  p.Ub = (unsigned char*)alloc((size_t)16384 * 1024);
  p.Vb = (unsigned char*)alloc((size_t)16384 * 1024);
  p.uS = (float*)alloc(16384 * 4);
  p.vS = (float*)alloc(16384 * 4);
  p.h = (u16*)alloc((size_t)T_ * 1024 * 2);
  p.z = (u16*)alloc((size_t)T_ * 2560 * 2);
  p.ycat = (u16*)alloc((size_t)T_ * 1024 * 2);
  p.hloc = (u16*)alloc((size_t)T_ * 512 * 2);
  p.logP = (u16*)alloc((size_t)T_ * 512 * 2);
  p.Hend = (float*)alloc(512 * 512 * 4);
  p.Pend = (float*)alloc(512 * 512 * 4);
  p.x1b = p.z;
  p.x2b = p.h;
  p.gsel = (float*)p.logP;
  p.Pd = p.ycat;
  p.coef16 = p.logP + (size_t)T_ * 128 * 2;
  p.idx16 = p.hloc;
  p.ssq = (float*)alloc((size_t)8 * T_ * 4);
  p.h8 = (signed char*)alloc((size_t)T_ * 1024);
  p.hS = (float*)alloc((size_t)T_ * 4);
  p.bar = (unsigned*)alloc(XCD_BAR_WORDS * 4);
  p.reps = 2; p.pad_ = 0;
#if MULTI_LAUNCH
  const int grid = 1024;
#define LAUNCH_PH(PH)                                                                              \
  hipFuncSetAttribute((const void*)k_phase<PH>, hipFuncAttributeMaxDynamicSharedMemorySize, LDS_BYTES); \
  k_phase<PH><<<grid, NT, LDS_BYTES, stream>>>(p);
  LAUNCH_PH(0) LAUNCH_PH(1) LAUNCH_PH(2) LAUNCH_PH(3) LAUNCH_PH(4)
  LAUNCH_PH(5) LAUNCH_PH(6) LAUNCH_PH(7) LAUNCH_PH(8) LAUNCH_PH(9) LAUNCH_PH(10) LAUNCH_PH(11)
#else
  static int grid_blocks = 0;
  hipFuncSetAttribute((const void*)mega, hipFuncAttributeMaxDynamicSharedMemorySize, LDS_BYTES);
  if (!grid_blocks) {
    int dev = 0, cus = 0, per_cu = 0;
    hipGetDevice(&dev);
    hipDeviceGetAttribute(&cus, hipDeviceAttributeMultiprocessorCount, dev);
    hipOccupancyMaxActiveBlocksPerMultiprocessor(&per_cu, mega, NT, LDS_BYTES);
    grid_blocks = cus * per_cu;
  }
  hipMemsetAsync(p.bar, 0, XCD_BAR_WORDS * 4, stream);
  void* args[] = {&p};
  hipError_t e = hipLaunchCooperativeKernel((void*)mega, dim3(grid_blocks), dim3(NT), args, LDS_BYTES, stream);
  if (e != hipSuccess) fprintf(stderr, "cooperative launch failed: %s (grid %d)\n", hipGetErrorString(e), grid_blocks);
#endif
}
```

```cpp
#include <hip/hip_runtime.h>
#include <hip/hip_cooperative_groups.h>
#include <cstdio>
namespace cg = cooperative_groups;

#ifndef MULTI_LAUNCH
#define MULTI_LAUNCH 0
#endif

typedef unsigned short u16;
using bf16x8 = __attribute__((ext_vector_type(8))) short;
using f32x16 = __attribute__((ext_vector_type(16))) float;

#define DEV __device__ __forceinline__
DEV int tidx() { int t = threadIdx.x; asm volatile("" : "+v"(t)); return t; }

constexpr int NT = 512;
constexpr int T_ = 65536;
constexpr int LDS_PHASE = 73728;
constexpr int LDS_BYTES = LDS_PHASE + 16;
constexpr int LROW = 144;
constexpr int STAGE = 256 * LROW;

struct Params {
  const float *x, *c, *w_ada, *b_ada, *norm1_g, *w_in, *conv_a_w, *conv_b_w, *conv_b_b;
  const float *w_r, *b_r, *w_i, *b_i, *lam, *gn_a, *gn_b, *w_out, *norm2_g, *w_q, *sub_keys;
  const float *expert_u, *expert_v, *final_g;
  float* out;
  float* ada;
  u16 *WinT, *WoutT, *WqT;
  u16 *keysF, *WrF, *WiF;
  unsigned char *Ub, *Vb;
  float *uS, *vS;
  u16 *h;
  u16 *z;
  u16 *ycat;
  u16 *hloc, *logP;
  float *Hend, *Pend;
  u16 *x1b;
  u16 *x2b;
  float* gsel;
  unsigned short* Pd;
  unsigned short* coef16;
  unsigned short* idx16;
  signed char* h8;
  float* hS;
  float* ssq;
  unsigned* bar;
  int reps; int pad_;
};

DEV u16 f2bf(float f) {
  unsigned u = __float_as_uint(f);
  u += 0x7FFFu + ((u >> 16) & 1u);
  return (u16)(u >> 16);
}
DEV float bf2f(u16 h) { return __uint_as_float(((unsigned)h) << 16); }
DEV unsigned pack2(float a, float b) { return (unsigned)f2bf(a) | ((unsigned)f2bf(b) << 16); }
DEV void unpack8(uint4 v, float* f) {
  f[0] = __uint_as_float(v.x << 16); f[1] = __uint_as_float(v.x & 0xFFFF0000u);
  f[2] = __uint_as_float(v.y << 16); f[3] = __uint_as_float(v.y & 0xFFFF0000u);
  f[4] = __uint_as_float(v.z << 16); f[5] = __uint_as_float(v.z & 0xFFFF0000u);
  f[6] = __uint_as_float(v.w << 16); f[7] = __uint_as_float(v.w & 0xFFFF0000u);
}
DEV unsigned pack_i8x4(float a, float b, float c, float d) {
  const int qa = (int)rintf(fminf(fmaxf(a, -127.f), 127.f)), qb = (int)rintf(fminf(fmaxf(b, -127.f), 127.f));
  const int qc = (int)rintf(fminf(fmaxf(c, -127.f), 127.f)), qd = (int)rintf(fminf(fmaxf(d, -127.f), 127.f));
  return (unsigned)(qa & 0xFF) | ((unsigned)(qb & 0xFF) << 8) | ((unsigned)(qc & 0xFF) << 16) | ((unsigned)(qd & 0xFF) << 24);
}
DEV float sigm(float x) { return 1.f / (1.f + __expf(-x)); }
DEV float gelu_tanh(float x) {
  float u = 0.7978845608028654f * (x + 0.044715f * x * x * x);
  float t = 1.f - 2.f / (1.f + __expf(2.f * u));
  return 0.5f * x * (1.f + t);
}
DEV float wave_allsum(float v) {
#pragma unroll
  for (int o = 32; o > 0; o >>= 1) v += __shfl_xor(v, o, 64);
  return v;
}
template <int CTRL> DEV unsigned dpp_u(unsigned v) {
  return (unsigned)__builtin_amdgcn_update_dpp((int)v, (int)v, CTRL, 0xF, 0xF, true);
}
DEV unsigned row_max_u(unsigned v) {
  v = max(v, dpp_u<0xB1>(v));
  v = max(v, dpp_u<0x4E>(v));
  v = max(v, dpp_u<0x141>(v));
  v = max(v, dpp_u<0x140>(v));
  return v;
}
DEV float row_sum_f(float v) {
  v += __uint_as_float(dpp_u<0xB1>(__float_as_uint(v)));
  v += __uint_as_float(dpp_u<0x4E>(__float_as_uint(v)));
  v += __uint_as_float(dpp_u<0x141>(__float_as_uint(v)));
  v += __uint_as_float(dpp_u<0x140>(__float_as_uint(v)));
  return v;
}
DEV unsigned sortable(float f) {
  unsigned k = __float_as_uint(f);
  return (k & 0x80000000u) ? ~k : (k | 0x80000000u);
}
DEV float unsortable(unsigned k) {
  return __uint_as_float((k & 0x80000000u) ? (k & 0x7FFFFFFFu) : ~k);
}
DEV f32x16 mfma32(bf16x8 a, bf16x8 b, f32x16 c) {
  return __builtin_amdgcn_mfma_f32_32x32x16_bf16(a, b, c, 0, 0, 0);
}
DEV int crow(int reg, int lane) { return (reg & 3) + 8 * (reg >> 2) + 4 * (lane >> 5); }

DEV void p0_ada(const Params& p, int item, char* smem) {
  float* sRed = (float*)smem;
  float* sC = (float*)(smem + 16384);
  const int tid = tidx(), w = tid >> 6, lane = tid & 63;
  const int col = item * 64 + lane;
#pragma unroll
  for (int i = 0; i < 16; ++i) {
    const int e = lane + 64 * i, b = e >> 7, kk = e & 127;
    const float cv = p.c[b * 1024 + w * 128 + kk];
    sC[w * 1024 + e] = cv / (1.f + __expf(-cv));
  }
  __syncthreads();
  float acc[8];
#pragma unroll
  for (int b = 0; b < 8; ++b) acc[b] = 0.f;
  const float* wp = p.w_ada + (size_t)(w * 128) * 6144 + col;
  const float* sc = sC + w * 1024;
#pragma unroll 64
  for (int kk = 0; kk < 128; ++kk) {
    const float wv = wp[(size_t)kk * 6144];
#pragma unroll
    for (int b = 0; b < 8; ++b) acc[b] += sc[b * 128 + kk] * wv;
  }
#pragma unroll
  for (int b = 0; b < 8; ++b) sRed[(w * 8 + b) * 64 + lane] = acc[b];
  __syncthreads();
  {
    const int b = tid >> 6, cl = tid & 63;
    float sum = 0.f;
#pragma unroll
    for (int w2 = 0; w2 < 8; ++w2) sum += sRed[(w2 * 8 + b) * 64 + cl];
    p.ada[b * 6144 + item * 64 + cl] = sum + p.b_ada[item * 64 + cl];
  }
  __syncthreads();
}

DEV void p0_transpose(const float* W, int K, int N, u16* Wt, int item, char* smem) {
  float* sT = (float*)smem;
  const int ntn = N >> 6;
  const int nt = item % ntn, kt = item / ntn;
  const int tid = tidx();
#pragma unroll
  for (int i = 0; i < 8; ++i) {
    const int e = tid + i * NT, r = e >> 6, c = e & 63;
    sT[r * 65 + c] = W[(size_t)(kt * 64 + r) * N + nt * 64 + c];
  }
  __syncthreads();
#pragma unroll
  for (int i = 0; i < 8; ++i) {
    const int e = tid + i * NT, r = e >> 6, c = e & 63;
    Wt[(size_t)(nt * 64 + r) * K + kt * 64 + c] = f2bf(sT[c * 65 + r]);
  }
  __syncthreads();
}

DEV void p0_keys(const Params& p, int item) {
#pragma unroll
  for (int i = 0; i < 8; ++i) {
    const int o = item * 4096 + i * NT + tidx();
    const int j = o & 7, lane = (o >> 3) & 63, kk = (o >> 9) & 3, nt = (o >> 11) & 3, hc = o >> 13;
    const int n = nt * 32 + (lane & 31), k = kk * 16 + (lane >> 5) * 8 + j;
    p.keysF[o] = f2bf(p.sub_keys[(hc * 128 + n) * 64 + k]);
  }
}
DEV void p0_gate(const float* W, u16* WF, int item) {
#pragma unroll
  for (int i = 0; i < 8; ++i) {
    const int o = item * 4096 + i * NT + tidx();
    const int j = o & 7, lane = (o >> 3) & 63, kk = (o >> 9) & 3, nt = (o >> 11) & 1, hh = o >> 12;
    const int n = nt * 32 + (lane & 31), k = kk * 16 + (lane >> 5) * 8 + j;
    WF[o] = f2bf(W[(hh * 64 + k) * 64 + n]);
  }
}
DEV void p0_expert(const float* src, unsigned char* dst, float* scl, int item) {
  const int lane = tidx() & 63, w = tidx() >> 6;
  const size_t e = (size_t)item * 8 + w;
  const float* rp = src + e * 1024 + lane * 16;
  float4 v[4];
  float am = 0.f;
#pragma unroll
  for (int i = 0; i < 4; ++i) {
    v[i] = *(const float4*)(rp + i * 4);
    am = fmaxf(am, fmaxf(fmaxf(fabsf(v[i].x), fabsf(v[i].y)), fmaxf(fabsf(v[i].z), fabsf(v[i].w))));
  }
#pragma unroll
  for (int o = 32; o > 0; o >>= 1) am = fmaxf(am, __shfl_xor(am, o, 64));
  am = fmaxf(am, 1e-30f);
  const float sc = 448.f / am;
  unsigned q[4];
#pragma unroll
  for (int i = 0; i < 4; ++i) {
    int t = __builtin_amdgcn_cvt_pk_fp8_f32(v[i].x * sc, v[i].y * sc, 0, false);
    t = __builtin_amdgcn_cvt_pk_fp8_f32(v[i].z * sc, v[i].w * sc, t, true);
    q[i] = (unsigned)t;
  }
  *(uint4*)(dst + (size_t)(lane >> 3) * (16384 * 128) + e * 128 + (lane & 7) * 16) = make_uint4(q[0], q[1], q[2], q[3]);
  if (lane == 0) scl[e] = am * (1.f / 448.f);
}
DEV void p0_expert_i8(const float* src, unsigned char* dst, float* scl, int item) {
  const int lane = tidx() & 63, w = tidx() >> 6;
  const size_t e = (size_t)item * 8 + w;
  const float* rp = src + e * 1024 + lane * 16;
  float4 v[4];
  float am = 0.f;
#pragma unroll
  for (int i = 0; i < 4; ++i) {
    v[i] = *(const float4*)(rp + i * 4);
    am = fmaxf(am, fmaxf(fmaxf(fabsf(v[i].x), fabsf(v[i].y)), fmaxf(fabsf(v[i].z), fabsf(v[i].w))));
  }
#pragma unroll
  for (int o = 32; o > 0; o >>= 1) am = fmaxf(am, __shfl_xor(am, o, 64));
  am = fmaxf(am, 1e-30f);
  const float sc = 127.f / am;
  unsigned q[4];
#pragma unroll
  for (int i = 0; i < 4; ++i) q[i] = pack_i8x4(v[i].x * sc, v[i].y * sc, v[i].z * sc, v[i].w * sc);
  *(uint4*)(dst + (size_t)(lane >> 3) * (16384 * 128) + e * 128 + (lane & 7) * 16) = make_uint4(q[0], q[1], q[2], q[3]);
  if (lane == 0) scl[e] = am * (1.f / 127.f);
}
constexpr int P0_ITEMS = 96 + 640 + 256 + 256 + 32 + 8 + 8 + 2048 + 2048;
DEV void phase0(const Params& p, int item, char* smem) {
  if (item < 96) { p0_ada(p, item, smem); return; }
  item -= 96;
  if (item < 640) { p0_transpose(p.w_in, 1024, 2560, p.WinT, item, smem); return; }
  item -= 640;
  if (item < 256) { p0_transpose(p.w_out, 1024, 1024, p.WoutT, item, smem); return; }
  item -= 256;
  if (item < 256) { p0_transpose(p.w_q, 1024, 1024, p.WqT, item, smem); return; }
  item -= 256;
  if (item < 32) { p0_keys(p, item); return; }
  item -= 32;
  if (item < 8) { p0_gate(p.w_r, p.WrF, item); return; }
  item -= 8;
  if (item < 8) { p0_gate(p.w_i, p.WiF, item); return; }
  item -= 8;
  if (item < 2048) { p0_expert_i8(p.expert_u, p.Ub, p.uS, item); return; }
  item -= 2048;
  p0_expert(p.expert_v, p.Vb, p.vS, item);
}

template <bool BF> DEV void p_norm_mod(const void* xin_, const float* g, const float* ada, int sh_off, int sc_off,
                    u16* hout, signed char* h8out, float* hSout, int item) {
  const int tid = tidx(), lane = tid & 63, w = tid >> 6;
  const int t0 = item * 64 + w * 8;
  const int b = t0 >> 13;
  float4 gg[4], sc[4], sh[4];
#pragma unroll
  for (int i = 0; i < 4; ++i) {
    gg[i] = *(const float4*)(g + i * 256 + lane * 4);
    sc[i] = *(const float4*)(ada + b * 6144 + sc_off + i * 256 + lane * 4);
    sh[i] = *(const float4*)(ada + b * 6144 + sh_off + i * 256 + lane * 4);
    gg[i].x *= (1.f + sc[i].x); gg[i].y *= (1.f + sc[i].y); gg[i].z *= (1.f + sc[i].z); gg[i].w *= (1.f + sc[i].w);
  }
#pragma unroll 2
  for (int tt = 0; tt < 8; ++tt) {
    const size_t t = t0 + tt;
    float4 xv[4];
    float ss = 0.f;
#pragma unroll
    for (int i = 0; i < 4; ++i) {
      if (BF) {
        const uint2 r2 = *(const uint2*)((const u16*)xin_ + t * 1024 + i * 256 + lane * 4);
        xv[i] = make_float4(__uint_as_float(r2.x << 16), __uint_as_float(r2.x & 0xFFFF0000u),
                            __uint_as_float(r2.y << 16), __uint_as_float(r2.y & 0xFFFF0000u));
      } else {
        xv[i] = *(const float4*)((const float*)xin_ + t * 1024 + i * 256 + lane * 4);
      }
      ss += xv[i].x * xv[i].x + xv[i].y * xv[i].y + xv[i].z * xv[i].z + xv[i].w * xv[i].w;
    }
    ss = wave_allsum(ss);
    const float rstd = rsqrtf(ss * (1.f / 1024.f) + 1e-6f);
    float am = 0.f;
#pragma unroll
    for (int i = 0; i < 4; ++i) {
      xv[i].x = xv[i].x * rstd * gg[i].x + sh[i].x; xv[i].y = xv[i].y * rstd * gg[i].y + sh[i].y;
      xv[i].z = xv[i].z * rstd * gg[i].z + sh[i].z; xv[i].w = xv[i].w * rstd * gg[i].w + sh[i].w;
      uint2 o;
      o.x = pack2(xv[i].x, xv[i].y);
      o.y = pack2(xv[i].z, xv[i].w);
      *(uint2*)(hout + t * 1024 + i * 256 + lane * 4) = o;
      if (BF) am = fmaxf(am, fmaxf(fmaxf(fabsf(xv[i].x), fabsf(xv[i].y)), fmaxf(fabsf(xv[i].z), fabsf(xv[i].w))));
    }
    if (BF) {
#pragma unroll
      for (int o = 32; o > 0; o >>= 1) am = fmaxf(am, __shfl_xor(am, o, 64));
      am = fmaxf(am, 1e-30f);
      const float qs = 127.f / am;
#pragma unroll
      for (int i = 0; i < 4; ++i)
        *(unsigned*)(h8out + t * 1024 + i * 256 + lane * 4) = pack_i8x4(xv[i].x * qs, xv[i].y * qs, xv[i].z * qs, xv[i].w * qs);
      if (lane == 0) hSout[t] = am * (1.f / 127.f);
    }
  }
}

DEV void gemm_core(const u16* __restrict__ A, const u16* __restrict__ Bt, int m0, int n0, char* smem,
                   f32x16& acc0, f32x16& acc1) {
  const int tid = tidx(), lane = tid & 63, w = tid >> 6, wr = w >> 1, wc = w & 1;
  const int lrow = tid >> 3, lc = tid & 7;
  const u16* ga = A + (size_t)(m0 + lrow) * 1024 + lc * 8;
  const u16* gb = Bt + (size_t)(n0 + lrow) * 1024 + lc * 8;
  const int lw = lrow * LROW + lc * 16;
  uint4 pa0, pa1, pb0, pb1, qa0, qa1, qb0, qb1;
  {
    const uint4 ra0 = *(const uint4*)ga, ra1 = *(const uint4*)(ga + 64 * 1024);
    const uint4 rb0 = *(const uint4*)gb, rb1 = *(const uint4*)(gb + 64 * 1024);
    __builtin_amdgcn_sched_barrier(0);
    pa0 = *(const uint4*)(ga + 64); pa1 = *(const uint4*)(ga + 64 * 1024 + 64);
    pb0 = *(const uint4*)(gb + 64); pb1 = *(const uint4*)(gb + 64 * 1024 + 64);
    __builtin_amdgcn_sched_barrier(0);
    qa0 = *(const uint4*)(ga + 128); qa1 = *(const uint4*)(ga + 64 * 1024 + 128);
    qb0 = *(const uint4*)(gb + 128); qb1 = *(const uint4*)(gb + 64 * 1024 + 128);
    __builtin_amdgcn_sched_barrier(0);
    *(uint4*)(smem + lw) = ra0;
    *(uint4*)(smem + lw + 64 * LROW) = ra1;
    *(uint4*)(smem + lw + 128 * LROW) = rb0;
    *(uint4*)(smem + lw + 192 * LROW) = rb1;
  }
  __syncthreads();
  const int a_off = (wr * 32 + (lane & 31)) * LROW + (lane >> 5) * 16;
  const int b_off = (128 + wc * 64 + (lane & 31)) * LROW + (lane >> 5) * 16;
#define GC128_COMPUTE(CUR)                                                              \
  _Pragma("unroll") for (int kk = 0; kk < 4; ++kk) {                                    \
    const bf16x8 a = *(const bf16x8*)((CUR) + a_off + kk * 32);                         \
    const bf16x8 b0 = *(const bf16x8*)((CUR) + b_off + kk * 32);                        \
    const bf16x8 b1 = *(const bf16x8*)((CUR) + b_off + 32 * LROW + kk * 32);            \
    acc0 = mfma32(a, b0, acc0);                                                         \
    acc1 = mfma32(a, b1, acc1);                                                         \
  }
#pragma unroll 1
  for (int kt = 0; kt < 16; kt += 2) {
    char* buf0 = smem;
    char* buf1 = smem + STAGE;
    GC128_COMPUTE(buf0)
    {
      *(uint4*)(buf1 + lw) = pa0;
      *(uint4*)(buf1 + lw + 64 * LROW) = pa1;
      *(uint4*)(buf1 + lw + 128 * LROW) = pb0;
      *(uint4*)(buf1 + lw + 192 * LROW) = pb1;
    }
    {
      const int ko = min(kt + 3, 15) * 64;
      pa0 = *(const uint4*)(ga + ko); pa1 = *(const uint4*)(ga + 64 * 1024 + ko);
      pb0 = *(const uint4*)(gb + ko); pb1 = *(const uint4*)(gb + 64 * 1024 + ko);
    }
    __syncthreads();
    GC128_COMPUTE(buf1)
    {
      *(uint4*)(buf0 + lw) = qa0;
      *(uint4*)(buf0 + lw + 64 * LROW) = qa1;
      *(uint4*)(buf0 + lw + 128 * LROW) = qb0;
      *(uint4*)(buf0 + lw + 192 * LROW) = qb1;
    }
    {
      const int ko = min(kt + 4, 15) * 64;
      qa0 = *(const uint4*)(ga + ko); qa1 = *(const uint4*)(ga + 64 * 1024 + ko);
      qb0 = *(const uint4*)(gb + ko); qb1 = *(const uint4*)(gb + 64 * 1024 + ko);
    }
    __syncthreads();
  }
#undef GC128_COMPUTE
}
DEV f32x16 zero16() {
  f32x16 z;
#pragma unroll
  for (int i = 0; i < 16; ++i) z[i] = 0.f;
  return z;
}

constexpr int LROW2 = 80;
constexpr int STAGE2 = 384 * LROW2;
DEV void gemm_core256(const u16* __restrict__ A, const u16* __restrict__ Bt, int m0, int n0, char* smem,
                      f32x16 (&acc)[2][2]) {
  const int tid = tidx(), lane = tid & 63, w = tid >> 6, wr = w >> 1, wc = w & 1;
  const int lrow = tid >> 2, lc = tid & 3;
  const u16* ga = A + (size_t)(m0 + lrow) * 1024 + lc * 8;
  const u16* gb = Bt + (size_t)(n0 + lrow) * 1024 + lc * 8;
  const int lw = lrow * LROW2 + lc * 16;
  uint4 pa0, pa1, pb0, qa0, qa1, qb0;
  {
    const uint4 ra0 = *(const uint4*)ga, ra1 = *(const uint4*)(ga + 128 * 1024), rb0 = *(const uint4*)gb;
    __builtin_amdgcn_sched_barrier(0);
    pa0 = *(const uint4*)(ga + 32); pa1 = *(const uint4*)(ga + 128 * 1024 + 32); pb0 = *(const uint4*)(gb + 32);
    __builtin_amdgcn_sched_barrier(0);
    qa0 = *(const uint4*)(ga + 64); qa1 = *(const uint4*)(ga + 128 * 1024 + 64); qb0 = *(const uint4*)(gb + 64);
    __builtin_amdgcn_sched_barrier(0);
    *(uint4*)(smem + lw) = ra0;
    *(uint4*)(smem + lw + 128 * LROW2) = ra1;
    *(uint4*)(smem + lw + 256 * LROW2) = rb0;
  }
  __syncthreads();
  const int a_off = (wr * 64 + (lane & 31)) * LROW2 + (lane >> 5) * 16;
  const int b_off = (256 + wc * 64 + (lane & 31)) * LROW2 + (lane >> 5) * 16;
#define GC256_COMPUTE(CUR)                                                              \
  _Pragma("unroll") for (int kk = 0; kk < 2; ++kk) {                                    \
    const bf16x8 a0 = *(const bf16x8*)((CUR) + a_off + kk * 32);                        \
    const bf16x8 a1 = *(const bf16x8*)((CUR) + a_off + 32 * LROW2 + kk * 32);           \
    const bf16x8 b0 = *(const bf16x8*)((CUR) + b_off + kk * 32);                        \
    const bf16x8 b1 = *(const bf16x8*)((CUR) + b_off + 32 * LROW2 + kk * 32);           \
    acc[0][0] = mfma32(a0, b0, acc[0][0]);                                              \
    acc[0][1] = mfma32(a0, b1, acc[0][1]);                                              \
    acc[1][0] = mfma32(a1, b0, acc[1][0]);                                              \
    acc[1][1] = mfma32(a1, b1, acc[1][1]);                                              \
  }
#pragma unroll 1
  for (int kt = 0; kt < 32; kt += 2) {
    char* buf0 = smem;
    char* buf1 = smem + STAGE2;
    GC256_COMPUTE(buf0)
    {
      *(uint4*)(buf1 + lw) = pa0;
      *(uint4*)(buf1 + lw + 128 * LROW2) = pa1;
      *(uint4*)(buf1 + lw + 256 * LROW2) = pb0;
    }
    {
      const int ko = min(kt + 3, 31) * 32;
      pa0 = *(const uint4*)(ga + ko); pa1 = *(const uint4*)(ga + 128 * 1024 + ko); pb0 = *(const uint4*)(gb + ko);
    }
    __syncthreads();
    GC256_COMPUTE(buf1)
    {
      *(uint4*)(buf0 + lw) = qa0;
      *(uint4*)(buf0 + lw + 128 * LROW2) = qa1;
      *(uint4*)(buf0 + lw + 256 * LROW2) = qb0;
    }
    {
      const int ko = min(kt + 4, 31) * 32;
      qa0 = *(const uint4*)(ga + ko); qa1 = *(const uint4*)(ga + 128 * 1024 + ko); qb0 = *(const uint4*)(gb + ko);
    }
    __syncthreads();
  }
#undef GC256_COMPUTE
}
DEV void stage_acc256(char* smem, const f32x16 (&acc)[2][2], int half) {
  float* sO = (float*)smem;
  const int tid = tidx(), lane = tid & 63, w = tid >> 6, wr = w >> 1, wc = w & 1;
  if ((wr >> 1) == half) {
    const int rb = (wr & 1) * 64, cb = wc * 64 + (lane & 31);
#pragma unroll
    for (int mi = 0; mi < 2; ++mi)
#pragma unroll
      for (int r = 0; r < 16; ++r) {
        const int row = rb + mi * 32 + crow(r, lane);
        sO[row * 132 + cb] = acc[mi][0][r];
        sO[row * 132 + cb + 32] = acc[mi][1][r];
      }
  }
  __syncthreads();
}
DEV void p2_gemm1(const Params& p, int item, char* smem) {
  const int xq = item / 640, j = item % 640;
  const int gid = j / 160, r = j % 160;
  const int mt = xq * 32 + gid * 8 + (r & 7), nt = r >> 3;
  f32x16 acc[2][2] = {{zero16(), zero16()}, {zero16(), zero16()}};
  gemm_core256(p.h, p.WinT, mt * 256, nt * 128, smem, acc);
  const float* sO = (const float*)smem;
  const int tid = tidx();
#pragma unroll
  for (int half = 0; half < 2; ++half) {
    stage_acc256(smem, acc, half);
#pragma unroll
    for (int i = 0; i < 4; ++i) {
      const int q = tid + i * NT, row = q >> 4, c8 = q & 15;
      const float4 a = *(const float4*)(sO + row * 132 + c8 * 8);
      const float4 b = *(const float4*)(sO + row * 132 + c8 * 8 + 4);
      *(uint4*)(p.z + (size_t)(mt * 256 + half * 128 + row) * 2560 + nt * 128 + c8 * 8) =
          make_uint4(pack2(a.x, a.y), pack2(a.z, a.w), pack2(b.x, b.y), pack2(b.z, b.w));
    }
    __syncthreads();
  }
}
DEV void p5_gemm2(const Params& p, int item, char* smem) {
  const int mt = item >> 3, nt = item & 7;
  f32x16 acc[2][2] = {{zero16(), zero16()}, {zero16(), zero16()}};
  gemm_core256(p.ycat, p.WoutT, mt * 256, nt * 128, smem, acc);
  const float* sO = (const float*)smem;
  const int tid = tidx();
  const int b = (mt * 256) >> 13;
  const int row0 = tid >> 4, c8 = tid & 15;
  const float* gp = p.ada + b * 6144 + 2048 + nt * 128 + c8 * 8;
  const float4 g0 = *(const float4*)gp, g1 = *(const float4*)(gp + 4);
#pragma unroll
  for (int half = 0; half < 2; ++half) {
    const float* xp = p.x + (size_t)(mt * 256 + half * 128 + row0) * 1024 + nt * 128 + c8 * 8;
    u16* op = p.x1b + (size_t)(mt * 256 + half * 128 + row0) * 1024 + nt * 128 + c8 * 8;
    float4 xa0 = *(const float4*)xp, xb0 = *(const float4*)(xp + 4);
    float4 xa1 = *(const float4*)(xp + 32 * 1024), xb1 = *(const float4*)(xp + 32 * 1024 + 4);
    stage_acc256(smem, acc, half);
    const float4 xa2 = *(const float4*)(xp + 64 * 1024), xb2 = *(const float4*)(xp + 64 * 1024 + 4);
    const float4 xa3 = *(const float4*)(xp + 96 * 1024), xb3 = *(const float4*)(xp + 96 * 1024 + 4);
#define P5_OUT(I, XA, XB) {                                                                                         \
      const float4 a0 = *(const float4*)(sO + (row0 + 32 * I) * 132 + c8 * 8);                                       \
      const float4 a1 = *(const float4*)(sO + (row0 + 32 * I) * 132 + c8 * 8 + 4);                                   \
      *(uint4*)(op + (size_t)(32 * I) * 1024) =                                                                      \
          make_uint4(pack2(XA.x + g0.x * a0.x, XA.y + g0.y * a0.y), pack2(XA.z + g0.z * a0.z, XA.w + g0.w * a0.w),    \
                     pack2(XB.x + g1.x * a1.x, XB.y + g1.y * a1.y), pack2(XB.z + g1.z * a1.z, XB.w + g1.w * a1.w)); }
    P5_OUT(0, xa0, xb0) P5_OUT(1, xa1, xb1) P5_OUT(2, xa2, xb2) P5_OUT(3, xa3, xb3)
#undef P5_OUT
    __syncthreads();
  }
}

constexpr int P3_WOFF = 71008;
DEV void p3_stage_head(const Params& p, int h, char* smem) {
  float* sWt = (float*)(smem + P3_WOFF);
  const int tid = tidx();
  __syncthreads();
  for (int e = tid; e < 9 * 64; e += NT) {
    const int r = e >> 6, c = e & 63;
    float v;
    if (r < 3) v = p.conv_a_w[r * 512 + h * 64 + c];
    else if (r < 7) v = p.conv_b_w[(r - 3) * 512 + h * 64 + c];
    else if (r == 7) v = p.conv_b_b[h * 64 + c];
    else v = p.gn_a[h * 64 + c];
    sWt[e] = v;
  }
  __syncthreads();
}
DEV void p3_mixer1(const Params& p, int item, char* smem) {
  const int tid = tidx(), lane = tid & 63, w = tid >> 6;
  const int tile = item >> 3, h = item & 7;
  const int t0 = tile * 128;
  const int tb = t0 & 8191;
  const float* sWt = (const float*)(smem + P3_WOFF);
  const uint4 ld_gb0 = *(const uint4*)(p.z + ((size_t)t0 + (tid >> 2)) * 2560 + h * 64 + (tid & 3) * 16);
  const uint4 ld_gb1 = *(const uint4*)(p.z + ((size_t)t0 + (tid >> 2)) * 2560 + h * 64 + (tid & 3) * 16 + 8);
  const int hc_e = h * 64 + (w & 1) * 32 + (lane & 31);
  const float ld_br = p.b_r[hc_e], ld_bi = p.b_i[hc_e], ld_lam = p.lam[hc_e];
  float* sXr = (float*)smem;
  float* sCx = (float*)(smem + 131 * 68 * 4);
  for (int q = tid; q < 131 * 8; q += NT) {
    const int r = q >> 3, c8 = q & 7;
    float f[8];
    if (tb + r - 3 >= 0) {
      const uint4 v = *(const uint4*)(p.z + (size_t)(t0 + r - 3) * 2560 + 1536 + h * 64 + c8 * 8);
      unpack8(v, f);
    } else {
#pragma unroll
      for (int j = 0; j < 8; ++j) f[j] = 0.f;
    }
    *(float4*)(sXr + r * 68 + c8 * 8) = make_float4(f[0], f[1], f[2], f[3]);
    *(float4*)(sXr + r * 68 + c8 * 8 + 4) = make_float4(f[4], f[5], f[6], f[7]);
  }
  for (int q = tid; q < 130 * 8; q += NT) {
    const int r = q >> 3, c8 = q & 7;
    float f[8], g[8];
    if (tb + r - 2 >= 0) {
      const u16* zr = p.z + (size_t)(t0 + r - 2) * 2560 + h * 64 + c8 * 8;
      const uint4 v = *(const uint4*)(zr + 512);
      const uint4 v2 = *(const uint4*)(zr + 1024);
      unpack8(v, f); unpack8(v2, g);
#pragma unroll
      for (int j = 0; j < 8; ++j) f[j] *= g[j];
    } else {
#pragma unroll
      for (int j = 0; j < 8; ++j) f[j] = 0.f;
    }
    *(float4*)(sCx + r * 68 + c8 * 8) = make_float4(f[0], f[1], f[2], f[3]);
    *(float4*)(sCx + r * 68 + c8 * 8 + 4) = make_float4(f[4], f[5], f[6], f[7]);
  }
  __syncthreads();
  const int tl = tid >> 2, q4 = tid & 3;
  const size_t t = (size_t)t0 + tl;
  const int cb = h * 64 + q4 * 16;
  {
    float gb[16], ya[16];
    unpack8(ld_gb0, gb);
    unpack8(ld_gb1, gb + 8);
    float ss = 0.f;
#pragma unroll
    for (int c4 = 0; c4 < 4; ++c4) {
      const float4 w0 = *(const float4*)(sWt + 0 * 64 + q4 * 16 + c4 * 4);
      const float4 w1 = *(const float4*)(sWt + 1 * 64 + q4 * 16 + c4 * 4);
      const float4 w2 = *(const float4*)(sWt + 2 * 64 + q4 * 16 + c4 * 4);
      const float4 x0 = *(const float4*)(sCx + (tl + 0) * 68 + q4 * 16 + c4 * 4);
      const float4 x1 = *(const float4*)(sCx + (tl + 1) * 68 + q4 * 16 + c4 * 4);
      const float4 x2 = *(const float4*)(sCx + (tl + 2) * 68 + q4 * 16 + c4 * 4);
      ya[c4 * 4 + 0] = gb[c4 * 4 + 0] * (w0.x * x0.x + w1.x * x1.x + w2.x * x2.x);
      ya[c4 * 4 + 1] = gb[c4 * 4 + 1] * (w0.y * x0.y + w1.y * x1.y + w2.y * x2.y);
      ya[c4 * 4 + 2] = gb[c4 * 4 + 2] * (w0.z * x0.z + w1.z * x1.z + w2.z * x2.z);
      ya[c4 * 4 + 3] = gb[c4 * 4 + 3] * (w0.w * x0.w + w1.w * x1.w + w2.w * x2.w);
      asm volatile("" ::: "memory");
    }
#pragma unroll
    for (int c = 0; c < 16; ++c) ss += ya[c] * ya[c];
    ss += __shfl_xor(ss, 1, 64);
    ss += __shfl_xor(ss, 2, 64);
    const float rstd = rsqrtf(ss * (1.f / 64.f) + 1e-6f);
    unsigned o[8];
#pragma unroll
    for (int c2 = 0; c2 < 8; ++c2)
      o[c2] = pack2(ya[c2 * 2] * rstd * sWt[8 * 64 + q4 * 16 + c2 * 2], ya[c2 * 2 + 1] * rstd * sWt[8 * 64 + q4 * 16 + c2 * 2 + 1]);
    *(uint4*)(p.ycat + t * 1024 + cb) = make_uint4(o[0], o[1], o[2], o[3]);
    *(uint4*)(p.ycat + t * 1024 + cb + 8) = make_uint4(o[4], o[5], o[6], o[7]);
  }
  unsigned xp[8];
#pragma unroll
  for (int c4 = 0; c4 < 4; ++c4) {
    const float4 w0 = *(const float4*)(sWt + 3 * 64 + q4 * 16 + c4 * 4);
    const float4 w1 = *(const float4*)(sWt + 4 * 64 + q4 * 16 + c4 * 4);
    const float4 w2 = *(const float4*)(sWt + 5 * 64 + q4 * 16 + c4 * 4);
    const float4 w3 = *(const float4*)(sWt + 6 * 64 + q4 * 16 + c4 * 4);
    const float4 bb = *(const float4*)(sWt + 7 * 64 + q4 * 16 + c4 * 4);
    const float4 x0 = *(const float4*)(sXr + (tl + 0) * 68 + q4 * 16 + c4 * 4);
    const float4 x1 = *(const float4*)(sXr + (tl + 1) * 68 + q4 * 16 + c4 * 4);
    const float4 x2 = *(const float4*)(sXr + (tl + 2) * 68 + q4 * 16 + c4 * 4);
    const float4 x3 = *(const float4*)(sXr + (tl + 3) * 68 + q4 * 16 + c4 * 4);
    const float vx = w0.x * x0.x + w1.x * x1.x + w2.x * x2.x + w3.x * x3.x + bb.x;
    const float vy = w0.y * x0.y + w1.y * x1.y + w2.y * x2.y + w3.y * x3.y + bb.y;
    const float vz = w0.z * x0.z + w1.z * x1.z + w2.z * x2.z + w3.z * x3.z + bb.z;
    const float vw = w0.w * x0.w + w1.w * x1.w + w2.w * x2.w + w3.w * x3.w + bb.w;
    xp[c4 * 2] = pack2(vx, vy); xp[c4 * 2 + 1] = pack2(vz, vw);
    asm volatile("" ::: "memory");
  }
  __syncthreads();
  u16* sXp = (u16*)smem;
  *(uint4*)(smem + tl * 144 + q4 * 32) = make_uint4(xp[0], xp[1], xp[2], xp[3]);
  *(uint4*)(smem + tl * 144 + q4 * 32 + 16) = make_uint4(xp[4], xp[5], xp[6], xp[7]);
  __syncthreads();
  const int mt = w >> 1, nt = w & 1;
  f32x16 accR = zero16(), accI = zero16();
#pragma unroll
  for (int kk = 0; kk < 4; ++kk) {
    const bf16x8 a = *(const bf16x8*)(smem + (mt * 32 + (lane & 31)) * 144 + kk * 32 + (lane >> 5) * 16);
    const size_t fo = (size_t)((((h * 2 + nt) * 4 + kk) * 64 + lane)) * 8;
    const bf16x8 br = *(const bf16x8*)(p.WrF + fo);
    const bf16x8 bi = *(const bf16x8*)(p.WiF + fo);
    accR = mfma32(a, br, accR);
    accI = mfma32(a, bi, accI);
  }
  const int j = nt * 32 + (lane & 31);
  const int hc = h * 64 + j;
  float xv[16];
#pragma unroll
  for (int r = 0; r < 16; ++r) xv[r] = bf2f(sXp[(mt * 32 + crow(r, lane)) * 72 + j]);
  __syncthreads();
  float* sLa = (float*)smem;
  float* sU = (float*)(smem + 32768);
  {
    const float br_ = ld_br, bi_ = ld_bi;
    const float sp = log1pf(expf(-ld_lam));
#pragma unroll
    for (int r = 0; r < 16; ++r) {
      const int tl2 = mt * 32 + crow(r, lane);
      const float rr = sigm(accR[r] + br_);
      const float ii = sigm(accI[r] + bi_);
      const float la = -8.f * rr * sp;
      const float u = sqrtf(-expm1f(2.f * la)) * ii * xv[r];
      sLa[tl2 * 64 + j] = la;
      sU[tl2 * 64 + j] = u;
      asm volatile("" ::: "memory");
    }
  }
  __syncthreads();
  const int seg = tid >> 6, ch = tid & 63;
  float* sSegA = (float*)(smem + 65536);
  float* sSegH = sSegA + 512;
  {
    float cum = 0.f, hh = 0.f;
#pragma unroll 4
    for (int i = 0; i < 16; ++i) {
      const int ix = (seg * 16 + i) * 64 + ch;
      const float la = sLa[ix], u = sU[ix];
      hh = __expf(la) * hh + u;
      cum += la;
      sU[ix] = hh; sLa[ix] = cum;
    }
    sSegA[seg * 64 + ch] = cum; sSegH[seg * 64 + ch] = hh;
  }
  __syncthreads();
  {
    float cH = 0.f, cL = 0.f;
#pragma unroll
    for (int s2 = 0; s2 < 7; ++s2) {
      if (s2 < seg) {
        const float A = sSegA[s2 * 64 + ch];
        cH = __expf(A) * cH + sSegH[s2 * 64 + ch];
        cL += A;
      }
    }
#pragma unroll 2
    for (int i = 0; i < 16; ++i) {
      const int ix = (seg * 16 + i) * 64 + ch;
      const float cs = sLa[ix];
      const float lp = cs + cL;
      const float hl = sU[ix] + __expf(cs) * cH;
      const size_t go = (size_t)(t0 + seg * 16 + i) * 512 + h * 64 + ch;
      p.hloc[go] = f2bf(hl);
      p.logP[go] = f2bf(lp);
      if (seg == 7 && i == 15) {
        p.Hend[tile * 512 + h * 64 + ch] = hl;
        p.Pend[tile * 512 + h * 64 + ch] = lp;
      }
    }
  }
  __syncthreads();
}

DEV void p4_mixer2(const Params& p, int item, char* smem) {
  const int tid = tidx();
  const int tile = item >> 3, h = item & 7;
  const int t0 = tile * 128;
  const int b = tile >> 6, cidx = tile & 63;
  float* sSegA = (float*)smem;
  float* sSegH = sSegA + 512;
  float* sCarry = sSegH + 512;
  const int seg = tid >> 6, ch = tid & 63;
  const int tl = tid >> 2, q4 = tid & 3;
  const size_t t = (size_t)t0 + tl;
  const int cb = h * 64 + q4 * 16;
  const uint4 ld_h0 = *(const uint4*)(p.hloc + t * 512 + cb), ld_h1 = *(const uint4*)(p.hloc + t * 512 + cb + 8);
  const uint4 ld_p0 = *(const uint4*)(p.logP + t * 512 + cb), ld_p1 = *(const uint4*)(p.logP + t * 512 + cb + 8);
  const uint4 ld_g0 = *(const uint4*)(p.z + t * 2560 + 2048 + cb), ld_g1 = *(const uint4*)(p.z + t * 2560 + 2048 + cb + 8);
  {
    float A = 0.f, H = 0.f;
#pragma unroll
    for (int i = 0; i < 8; ++i) {
      const int c2 = seg * 8 + i;
      if (c2 < cidx) {
        const size_t o = (size_t)(b * 64 + c2) * 512 + h * 64 + ch;
        const float pl = p.Pend[o];
        H = __expf(pl) * H + p.Hend[o];
        A += pl;
      }
    }
    sSegA[seg * 64 + ch] = A; sSegH[seg * 64 + ch] = H;
  }
  __syncthreads();
  if (tid < 64) {
    float cH = 0.f;
#pragma unroll
    for (int s2 = 0; s2 < 8; ++s2) cH = __expf(sSegA[s2 * 64 + ch]) * cH + sSegH[s2 * 64 + ch];
    sCarry[ch] = cH;
  }
  __syncthreads();
  float hl[16], lp[16], gr[16], yb[16];
  unpack8(ld_h0, hl); unpack8(ld_h1, hl + 8);
  unpack8(ld_p0, lp); unpack8(ld_p1, lp + 8);
  unpack8(ld_g0, gr); unpack8(ld_g1, gr + 8);
  float ss = 0.f;
#pragma unroll
  for (int c = 0; c < 16; ++c) {
    const float hv = hl[c] + __expf(lp[c]) * sCarry[q4 * 16 + c];
    yb[c] = hv * gelu_tanh(gr[c]);
    ss += yb[c] * yb[c];
  }
  ss += __shfl_xor(ss, 1, 64);
  ss += __shfl_xor(ss, 2, 64);
  const float rstd = rsqrtf(ss * (1.f / 64.f) + 1e-6f);
  unsigned o[8];
#pragma unroll
  for (int c2 = 0; c2 < 8; ++c2)
    o[c2] = pack2(yb[c2 * 2] * rstd * p.gn_b[cb + c2 * 2], yb[c2 * 2 + 1] * rstd * p.gn_b[cb + c2 * 2 + 1]);
  *(uint4*)(p.ycat + t * 1024 + 512 + cb) = make_uint4(o[0], o[1], o[2], o[3]);
  *(uint4*)(p.ycat + t * 1024 + 512 + cb + 8) = make_uint4(o[4], o[5], o[6], o[7]);
  __syncthreads();
}

__constant__ unsigned FTAB[16] = {0x03020100u, 0x07060504u, 0x0B0A0908u, 0x0F0E0D0Cu, 0x13121110u, 0x17161514u, 0x23222120u, 0x33323130u,
                                  0x24424140u, 0x61605150u, 0x90807170u, 0xD0C0B0A0u, 0xFFFFF0E0u, 0xFFFFFFFFu, 0xFFFFFFFFu, 0xFFFFFFFFu};
DEV void p7_route(const Params& p, int item, char* smem) {
  const int tid = tidx(), lane = tid & 63, w = tid >> 6;
  const int mt = item >> 3, hh = item & 7;
  const int m0 = mt * 128;
  const int rg = lane >> 4, li = lane & 15;
  bf16x8 bkf[4];
#pragma unroll
  for (int kk = 0; kk < 4; ++kk)
    bkf[kk] = *(const bf16x8*)(p.keysF + (size_t)(((((hh * 2 + (w >> 2)) * 4 + (w & 3)) * 4 + kk) * 64 + lane)) * 8);
  const unsigned tabw = FTAB[li];
  f32x16 acc0 = zero16(), acc1 = zero16();
  gemm_core(p.h, p.WqT, m0, hh * 128, smem, acc0, acc1);
  u16* sQ = (u16*)smem;
  float* sS = (float*)(smem + 34816);
  unsigned* sTop = (unsigned*)(smem + 34816 + 34816);
  {
    const int wr = w >> 1, wc = w & 1;
#pragma unroll
    for (int r = 0; r < 16; ++r) {
      const int row = wr * 32 + crow(r, lane);
      sQ[row * 136 + wc * 64 + (lane & 31)] = f2bf(acc0[r]);
      sQ[row * 136 + wc * 64 + 32 + (lane & 31)] = f2bf(acc1[r]);
    }
  }
  __syncthreads();
#pragma unroll 1
  for (int chunk = 0; chunk < 4; ++chunk) {
    {
      const int c = w >> 2, nt = w & 3;
      f32x16 s = zero16();
#pragma unroll
      for (int kk = 0; kk < 4; ++kk) {
        const bf16x8 a = *(const bf16x8*)(smem + (chunk * 32 + (lane & 31)) * 272 +
                                          (c * 64 + kk * 16 + (lane >> 5) * 8) * 2);
        s = mfma32(a, bkf[kk], s);
      }
#pragma unroll
      for (int r = 0; r < 16; ++r) sS[(c * 32 + crow(r, lane)) * 136 + nt * 32 + (lane & 31)] = s[r];
    }
    __syncthreads();
    const int tokl = w * 4 + rg;
    unsigned res[2];
#pragma unroll
    for (int c = 0; c < 2; ++c) {
      unsigned k[8];
#pragma unroll
      for (int jj = 0; jj < 8; ++jj) {
        const float v = sS[(c * 32 + tokl) * 136 + li + 16 * jj];
        k[jj] = (sortable(v) & ~127u) | (unsigned)(li + 16 * jj);
      }
#define CE_(i, j) { const unsigned hi_ = max(k[i], k[j]), lo_ = min(k[i], k[j]); k[i] = hi_; k[j] = lo_; }
      CE_(0, 1) CE_(2, 3) CE_(4, 5) CE_(6, 7) CE_(0, 2) CE_(1, 3) CE_(4, 6) CE_(5, 7) CE_(1, 2) CE_(5, 6)
      CE_(0, 4) CE_(1, 5) CE_(2, 6) CE_(3, 7) CE_(2, 4) CE_(3, 5) CE_(1, 2) CE_(3, 4) CE_(5, 6)
#undef CE_
      unsigned r_ = 0;
#pragma unroll
      for (int it = 0; it < 16; ++it) {
        const unsigned m = row_max_u(k[0]);
        const bool win = (k[0] == m);
        r_ = (li == it) ? m : r_;
#pragma unroll
        for (int jj = 0; jj < 7; ++jj) k[jj] = win ? k[jj + 1] : k[jj];
        k[7] = win ? 0u : k[7];
      }
      res[c] = r_;
    }
    unsigned* tp = sTop + (w * 4 + rg) * 32;
    tp[li] = res[0];
    tp[16 + li] = res[1];
    __syncthreads();
    {
      unsigned ck[4];
#pragma unroll
      for (int j = 0; j < 4; ++j) {
        const unsigned code = (tabw >> (8 * j)) & 0xFFu;
        const float s0 = unsortable(tp[code >> 4] & ~127u);
        const float s1 = unsortable(tp[16 + (code & 15u)] & ~127u);
        const unsigned key = (sortable(s0 + s1) & ~255u) | code;
        ck[j] = (code == 0xFFu) ? 0u : key;
      }
#define CE4_(i, j) { const unsigned hi_ = max(ck[i], ck[j]), lo_ = min(ck[i], ck[j]); ck[i] = hi_; ck[j] = lo_; }
      CE4_(0, 1) CE4_(2, 3) CE4_(0, 2) CE4_(1, 3) CE4_(1, 2)
#undef CE4_
      unsigned r_ = 0;
#pragma unroll
      for (int it = 0; it < 16; ++it) {
        const unsigned m = row_max_u(ck[0]);
        const bool win = (ck[0] == m);
        r_ = (li == it) ? m : r_;
        ck[0] = win ? ck[1] : ck[0];
        ck[1] = win ? ck[2] : ck[1];
        ck[2] = win ? ck[3] : ck[2];
        ck[3] = win ? 0u : ck[3];
      }
      const int pos = r_ & 255;
      const int i0 = tp[pos >> 4] & 127, i1 = tp[16 + (pos & 15)] & 127;
      const float bs = unsortable(r_ & ~255u);
      const float mx = unsortable(row_max_u(r_) & ~255u);
      const float e = __expf(bs - mx);
      const float sum = row_sum_f(e);
      const size_t tg = (size_t)m0 + chunk * 32 + tokl;
      p.idx16[tg * 128 + hh * 16 + li] = (unsigned short)(i0 * 128 + i1);
      p.gsel[tg * 128 + hh * 16 + li] = e / sum;
    }
    __syncthreads();
  }
}

DEV void unpack_fp8x16(uint4 v, float* f) {
  typedef float f2_t __attribute__((ext_vector_type(2)));
  f2_t r;
  r = __builtin_amdgcn_cvt_pk_f32_fp8((int)v.x, false); f[0] = r.x; f[1] = r.y;
  r = __builtin_amdgcn_cvt_pk_f32_fp8((int)v.x, true);  f[2] = r.x; f[3] = r.y;
  r = __builtin_amdgcn_cvt_pk_f32_fp8((int)v.y, false); f[4] = r.x; f[5] = r.y;
  r = __builtin_amdgcn_cvt_pk_f32_fp8((int)v.y, true);  f[6] = r.x; f[7] = r.y;
  r = __builtin_amdgcn_cvt_pk_f32_fp8((int)v.z, false); f[8] = r.x; f[9] = r.y;
  r = __builtin_amdgcn_cvt_pk_f32_fp8((int)v.z, true);  f[10] = r.x; f[11] = r.y;
  r = __builtin_amdgcn_cvt_pk_f32_fp8((int)v.w, false); f[12] = r.x; f[13] = r.y;
  r = __builtin_amdgcn_cvt_pk_f32_fp8((int)v.w, true);  f[14] = r.x; f[15] = r.y;
}
typedef _Float16 h2_t __attribute__((ext_vector_type(2)));
DEV unsigned packh2(float a, float b) {
  h2_t v; v.x = (_Float16)a; v.y = (_Float16)b;
  return __builtin_bit_cast(unsigned, v);
}
DEV float sum8_f(float v) {
  v += __uint_as_float(dpp_u<0xB1>(__float_as_uint(v)));
  v += __uint_as_float(dpp_u<0x4E>(__float_as_uint(v)));
  v += __uint_as_float(dpp_u<0x141>(__float_as_uint(v)));
  return v;
}
DEV unsigned id_of(const unsigned* w, int i) { return (i & 1) ? (w[i >> 1] >> 16) : (w[i >> 1] & 0xFFFFu); }
DEV float half_of(const unsigned* w, int i) {
  const unsigned short b = (i & 1) ? (unsigned short)(w[i >> 1] >> 16) : (unsigned short)(w[i >> 1] & 0xFFFFu);
  return (float)__builtin_bit_cast(_Float16, b);
}
DEV void p8_udots_all(const Params& p) {
  const int tid = tidx(), lane = tid & 63, w = tid >> 6;
  const int es = lane >> 3, cl = lane & 7;
  const unsigned lo = cl * 16;
  const int n = 65536;
  int v = blockIdx.x;
  if (v >= n) return;
  uint4 i0, i1, hq;
  {
    const size_t t = (size_t)(v >> 3) * 8 + w;
    i0 = *(const uint4*)(p.idx16 + t * 128 + es * 16);
    i1 = *(const uint4*)(p.idx16 + t * 128 + es * 16 + 8);
    hq = *(const uint4*)(p.h8 + t * 1024 + (v & 7) * 128 + cl * 16);
  }
#pragma unroll 1
  for (; v < n; v += gridDim.x) {
    const int x = v & 7;
    const size_t t = (size_t)(v >> 3) * 8 + w;
    const unsigned idw[8] = {i0.x, i0.y, i0.z, i0.w, i1.x, i1.y, i1.z, i1.w};
    const uint4 hcur = hq;
    const unsigned char* ub = p.Ub + (size_t)x * (16384 * 128);
    uint4 raw[16];
#pragma unroll
    for (int i = 0; i < 16; ++i) raw[i] = *(const uint4*)(ub + (id_of(idw, i) * 128u + lo));
    {
      const int vn = min(v + (int)gridDim.x, n - 8 + x);
      const size_t tn = (size_t)(vn >> 3) * 8 + w;
      i0 = *(const uint4*)(p.idx16 + tn * 128 + es * 16);
      i1 = *(const uint4*)(p.idx16 + tn * 128 + es * 16 + 8);
      hq = *(const uint4*)(p.h8 + tn * 1024 + x * 128 + cl * 16);
    }
    __builtin_amdgcn_sched_barrier(0);
    unsigned dp[8];
#pragma unroll
    for (int i2 = 0; i2 < 8; ++i2) {
      float dd[2];
#pragma unroll
      for (int k = 0; k < 2; ++k) {
        const uint4 rw = raw[i2 * 2 + k];
        int isum = __builtin_amdgcn_sdot4((int)rw.x, (int)hcur.x, 0, false);
        isum = __builtin_amdgcn_sdot4((int)rw.y, (int)hcur.y, isum, false);
        isum = __builtin_amdgcn_sdot4((int)rw.z, (int)hcur.z, isum, false);
        isum = __builtin_amdgcn_sdot4((int)rw.w, (int)hcur.w, isum, false);
        unsigned us = (unsigned)isum;
        us += dpp_u<0xB1>(us); us += dpp_u<0x4E>(us); us += dpp_u<0x141>(us);
        asm volatile("" : "+v"(us));
        dd[k] = (float)(int)us * (1.f / 256.f);
        __builtin_amdgcn_sched_barrier(0);
      }
      dp[i2] = packh2(dd[0], dd[1]);
    }
    if (cl == 0) {
      unsigned short* pp = p.Pd + (t * 8 + (size_t)x) * 128 + es * 16;
      *(uint4*)pp = make_uint4(dp[0], dp[1], dp[2], dp[3]);
      *(uint4*)(pp + 8) = make_uint4(dp[4], dp[5], dp[6], dp[7]);
    }
  }
}
DEV void p8_coef(const Params& p, int item) {
  const int tid = tidx(), lane = tid & 63, w = tid >> 6;
  const size_t t0 = (size_t)item * 32 + w * 4;
  float s0[4], s1[4];
  unsigned iw[4];
  float2 gv[4];
#pragma unroll
  for (int k = 0; k < 4; ++k) {
    const size_t t = t0 + k;
    s0[k] = 0.f; s1[k] = 0.f;
#pragma unroll
    for (int x = 0; x < 8; ++x) {
      const unsigned pv = *(const unsigned*)(p.Pd + (t * 8 + (size_t)x) * 128 + lane * 2);
      s0[k] += half_of(&pv, 0); s1[k] += half_of(&pv, 1);
    }
    iw[k] = *(const unsigned*)(p.idx16 + t * 128 + lane * 2);
    gv[k] = *(const float2*)(p.gsel + t * 128 + lane * 2);
  }
#pragma unroll
  for (int k = 0; k < 4; ++k) {
    const size_t t = t0 + k;
    const unsigned ia = iw[k] & 0xFFFFu, ib = iw[k] >> 16;
    const float hs = 256.f * p.hS[t];
    const float d0 = s0[k] * p.uS[ia] * hs, d1 = s1[k] * p.uS[ib] * hs;
    const float a0 = 0.5f * d0 * (1.f + erff(d0 * 0.7071067811865476f));
    const float a1 = 0.5f * d1 * (1.f + erff(d1 * 0.7071067811865476f));
    *(unsigned*)(p.coef16 + t * 128 + lane * 2) = packh2(1024.f * gv[k].x * a0 * p.vS[ia], 1024.f * gv[k].y * a1 * p.vS[ib]);
  }
}
DEV void p8_vacc_all(const Params& p, char* smem) {
  const int tid = tidx(), lane = tid & 63, w = tid >> 6;
  const int es = lane >> 3, cl = lane & 7;
  const unsigned lo = cl * 16;
  const int n = 65536;
  int v = blockIdx.x;
  if (v >= n) return;
  unsigned idw[8];
  uint4 rA[8];
  {
    const size_t t = (size_t)(v >> 3) * 8 + w;
    const uint4 i0 = *(const uint4*)(p.idx16 + t * 128 + es * 16);
    const uint4 i1 = *(const uint4*)(p.idx16 + t * 128 + es * 16 + 8);
    idw[0] = i0.x; idw[1] = i0.y; idw[2] = i0.z; idw[3] = i0.w; idw[4] = i1.x; idw[5] = i1.y; idw[6] = i1.z; idw[7] = i1.w;
    const unsigned char* vb0 = p.Vb + (size_t)(v & 7) * (16384 * 128);
#pragma unroll
    for (int i = 0; i < 8; ++i) rA[i] = *(const uint4*)(vb0 + (id_of(idw, i) * 128u + lo));
  }
#define V_CONSUME(RW, I)                                                                                   \
  {                                                                                                        \
    const h2_t cpair = __builtin_bit_cast(h2_t, cw[(I) >> 1]);                                             \
    h2_t cf2;                                                                                              \
    cf2.x = ((I) & 1) ? cpair.y : cpair.x; cf2.y = cf2.x;                                                  \
    const unsigned wds[4] = {(RW).x, (RW).y, (RW).z, (RW).w};                                              \
    _Pragma("unroll") for (int d4 = 0; d4 < 4; ++d4) {                                                     \
      const h2_t v0 = __builtin_amdgcn_cvt_scalef32_pk_f16_fp8(wds[d4], 1.0f, false);                      \
      const h2_t v1 = __builtin_amdgcn_cvt_scalef32_pk_f16_fp8(wds[d4], 1.0f, true);                       \
      acc2[d4 * 2] = cf2 * v0 + acc2[d4 * 2];                                                              \
      acc2[d4 * 2 + 1] = cf2 * v1 + acc2[d4 * 2 + 1];                                                      \
    }                                                                                                      \
    asm volatile("" : "+v"(acc2[0]), "+v"(acc2[1]), "+v"(acc2[2]), "+v"(acc2[3]), "+v"(acc2[4]), "+v"(acc2[5]), "+v"(acc2[6]), "+v"(acc2[7])); \
    __builtin_amdgcn_sched_barrier(0);                                                                     \
  }
#pragma unroll 1
  for (; v < n; v += gridDim.x) {
    const int x = v & 7;
    const size_t t = (size_t)(v >> 3) * 8 + w;
    const uint4 c0 = *(const uint4*)(p.coef16 + t * 128 + es * 16);
    const uint4 c1 = *(const uint4*)(p.coef16 + t * 128 + es * 16 + 8);
    const unsigned cw[8] = {c0.x, c0.y, c0.z, c0.w, c1.x, c1.y, c1.z, c1.w};
    const unsigned char* vb = p.Vb + (size_t)x * (16384 * 128);
    uint4 rB[8];
#pragma unroll
    for (int i = 0; i < 8; ++i) rB[i] = *(const uint4*)(vb + (id_of(idw, 8 + i) * 128u + lo));
    const int vn = min(v + (int)gridDim.x, n - 8 + x);
    const size_t tn = (size_t)(vn >> 3) * 8 + w;
    {
      const uint4 n0 = *(const uint4*)(p.idx16 + tn * 128 + es * 16);
      const uint4 n1 = *(const uint4*)(p.idx16 + tn * 128 + es * 16 + 8);
      idw[0] = n0.x; idw[1] = n0.y; idw[2] = n0.z; idw[3] = n0.w; idw[4] = n1.x; idw[5] = n1.y; idw[6] = n1.z; idw[7] = n1.w;
    }
    __builtin_amdgcn_sched_barrier(0);
    h2_t acc2[8];
#pragma unroll
    for (int j = 0; j < 8; ++j) { acc2[j].x = (_Float16)0.f; acc2[j].y = (_Float16)0.f; }
    const int b = (int)(t >> 13);
    const int col = x * 128 + lane * 2;
#pragma unroll
    for (int i = 0; i < 8; ++i) V_CONSUME(rA[i], i)
#pragma unroll
    for (int i = 0; i < 8; ++i) rA[i] = *(const uint4*)(vb + (id_of(idw, i) * 128u + lo));
    __builtin_amdgcn_sched_barrier(0);
#pragma unroll
    for (int i = 0; i < 8; ++i) V_CONSUME(rB[i], 8 + i)
    const float2 gv = *(const float2*)(p.ada + b * 6144 + 5120 + col);
    const unsigned xw = *(const unsigned*)(p.x1b + t * 1024 + col);
    unsigned* sWh = (unsigned*)smem + w * (8 * 68);
    *(uint4*)(sWh + es * 68 + cl * 8) = make_uint4(__builtin_bit_cast(unsigned, acc2[0]), __builtin_bit_cast(unsigned, acc2[1]),
                                                   __builtin_bit_cast(unsigned, acc2[2]), __builtin_bit_cast(unsigned, acc2[3]));
    *(uint4*)(sWh + es * 68 + cl * 8 + 4) = make_uint4(__builtin_bit_cast(unsigned, acc2[4]), __builtin_bit_cast(unsigned, acc2[5]),
                                                       __builtin_bit_cast(unsigned, acc2[6]), __builtin_bit_cast(unsigned, acc2[7]));
    __builtin_amdgcn_fence(__ATOMIC_RELEASE, "wavefront");
    __builtin_amdgcn_wave_barrier();
    __builtin_amdgcn_fence(__ATOMIC_ACQUIRE, "wavefront");
    h2_t hsum = __builtin_bit_cast(h2_t, sWh[lane]);
#pragma unroll
    for (int e2 = 1; e2 < 8; ++e2) hsum = hsum + __builtin_bit_cast(h2_t, sWh[e2 * 68 + lane]);
    const float o0 = (float)hsum.x, o1 = (float)hsum.y;
    __builtin_amdgcn_fence(__ATOMIC_RELEASE, "wavefront");
    __builtin_amdgcn_wave_barrier();
    const float2 xv = make_float2(__uint_as_float(xw << 16), __uint_as_float(xw & 0xFFFF0000u));
    float2 o;
    o.x = xv.x + gv.x * (o0 * (1.f / 1024.f)); o.y = xv.y + gv.y * (o1 * (1.f / 1024.f));
    *(unsigned*)(p.x2b + t * 1024 + col) = pack2(o.x, o.y);
  }
#undef V_CONSUME
}
DEV void p8_final(const Params& p, int item) {
  const int tid = tidx(), lane = tid & 63, w = tid >> 6;
  const size_t t0 = (size_t)item * 32 + w * 4;
  float4 fg[4];
#pragma unroll
  for (int i = 0; i < 4; ++i) fg[i] = *(const float4*)(p.final_g + i * 256 + lane * 4);
  uint2 r2[4][4];
#pragma unroll
  for (int k = 0; k < 4; ++k)
#pragma unroll
    for (int i = 0; i < 4; ++i) r2[k][i] = *(const uint2*)(p.x2b + (t0 + k) * 1024 + i * 256 + lane * 4);
#pragma unroll
  for (int k = 0; k < 4; ++k) {
    const size_t t = t0 + k;
    float xv[16];
    float ss = 0.f;
#pragma unroll
    for (int i = 0; i < 4; ++i) {
      xv[i * 4 + 0] = __uint_as_float(r2[k][i].x << 16); xv[i * 4 + 1] = __uint_as_float(r2[k][i].x & 0xFFFF0000u);
      xv[i * 4 + 2] = __uint_as_float(r2[k][i].y << 16); xv[i * 4 + 3] = __uint_as_float(r2[k][i].y & 0xFFFF0000u);
      ss += xv[i * 4] * xv[i * 4] + xv[i * 4 + 1] * xv[i * 4 + 1] + xv[i * 4 + 2] * xv[i * 4 + 2] + xv[i * 4 + 3] * xv[i * 4 + 3];
    }
    ss = wave_allsum(ss);
    const float r = rsqrtf(ss * (1.f / 1024.f) + 1e-6f);
#pragma unroll
    for (int i = 0; i < 4; ++i)
      *(float4*)(p.out + t * 1024 + i * 256 + lane * 4) =
          make_float4(xv[i * 4] * r * fg[i].x, xv[i * 4 + 1] * r * fg[i].y, xv[i * 4 + 2] * r * fg[i].z, xv[i * 4 + 3] * r * fg[i].w);
  }
}

#define XB_TMO      128
#define XB_XCNT(j)  (256  + 64 * (j))
#define XB_XSUB(j)  (1280 + 64 * (j))
#define XB_XGEN(j)  (2304 + 64 * (j))
#define XB_TOP      3328
#define XB_TOPGEN   3392
#define XCD_BAR_WORDS 3456
#define XB_SPIN_CAP (1u << 22)
#define LAS __attribute__((address_space(3)))
DEV unsigned xb_ld(unsigned* p)              { return __hip_atomic_load(p, __ATOMIC_RELAXED, __HIP_MEMORY_SCOPE_AGENT); }
DEV unsigned xb_add(unsigned* p, unsigned v) { return __hip_atomic_fetch_add(p, v, __ATOMIC_RELAXED, __HIP_MEMORY_SCOPE_AGENT); }
DEV unsigned xb_xcc_id() { return (unsigned)__builtin_amdgcn_s_getreg((3 << 11) | 20) & 0xFu; }
#define XB_SPIN(cond, bar) do { unsigned _sp = 0; while (cond) { __builtin_amdgcn_s_sleep(1); \
    if ((++_sp & 255u) == 0u) { if (xb_ld(&(bar)[XB_TMO])) break; if (_sp > XB_SPIN_CAP) { atomicAdd(&(bar)[XB_TMO], 1u); break; } } } } while (0)
struct XcdBarrier { unsigned* bar; unsigned x; volatile LAS unsigned* st; };
DEV XcdBarrier xcd_barrier_post(unsigned* bar, volatile LAS unsigned* st) {
  XcdBarrier b; b.bar = bar; b.x = xb_xcc_id(); b.st = st;
  if (threadIdx.x == 0) (void)xb_add(&bar[XB_XCNT(b.x)], 1u);
  return b;
}
DEV void xcd_barrier_complete(unsigned* bar, unsigned x, unsigned& nloc, unsigned& nx) {
  const unsigned G = gridDim.x * gridDim.y * gridDim.z;
  unsigned sum, cnt, mine, sp = 0u;
  for (;;) {
    sum = 0u; cnt = 0u; mine = 0u;
#pragma unroll
    for (unsigned j = 0; j < 16; ++j) { const unsigned c = xb_ld(&bar[XB_XCNT(j)]); sum += c; cnt += (c > 0u) ? 1u : 0u; mine = (j == x) ? c : mine; }
    if (sum == G) break;
    __builtin_amdgcn_s_sleep(1);
    if ((++sp & 255u) == 0u) { if (xb_ld(&bar[XB_TMO])) break; if (sp > XB_SPIN_CAP) { atomicAdd(&bar[XB_TMO], 1u); break; } }
  }
  nloc = mine > 0u ? mine : 1u; nx = cnt > 0u ? cnt : 1u;
}
DEV void xcd_barrier(const XcdBarrier& b) {
  asm volatile("s_waitcnt vmcnt(0)" ::: "memory");
  __syncthreads();
  if (threadIdx.x == 0) {
    unsigned* bar = b.bar;
    __builtin_amdgcn_s_waitcnt(0);
    unsigned nloc = b.st[0], nx = b.st[1];
    if (nloc == 0u) { xcd_barrier_complete(bar, b.x, nloc, nx); b.st[0] = nloc; b.st[1] = nx; }
    const unsigned old = xb_add(&bar[XB_XSUB(b.x)], 1u);
    const unsigned gen = old / nloc;
    if (old + 1u == (gen + 1u) * nloc) {
      __builtin_amdgcn_fence(__ATOMIC_RELEASE, "agent");
      asm volatile("s_waitcnt vmcnt(0)" ::: "memory");
      const unsigned og = xb_add(&bar[XB_TOP], 1u);
      const unsigned tg = og / nx;
      if (og + 1u == (tg + 1u) * nx) xb_add(&bar[XB_TOPGEN], 1u);
      else XB_SPIN(xb_ld(&bar[XB_TOPGEN]) == tg, bar);
      __builtin_amdgcn_fence(__ATOMIC_ACQUIRE, "agent");
      xb_add(&bar[XB_XGEN(b.x)], 1u);
      asm volatile("s_waitcnt vmcnt(0)" ::: "memory");
    } else {
      XB_SPIN(xb_ld(&bar[XB_XGEN(b.x)]) == gen, bar);
      __builtin_amdgcn_fence(__ATOMIC_ACQUIRE, "agent");
      asm volatile("s_waitcnt vmcnt(0)" ::: "memory");
    }
  }
  __syncthreads();
}

DEV int xcd_swz(int v, int n) { return (v & 7) * (n >> 3) + (v >> 3); }

template <int PH> DEV void run_phase(const Params& p, char* smem) {
  if (PH == 3) {
    int hcur = -1;
#pragma unroll 1
    for (int v = blockIdx.x; v < 4096; v += gridDim.x) {
      const int h = v & 7;
      if (h != hcur) { p3_stage_head(p, h, smem); hcur = h; }
      p3_mixer1(p, v, smem);
    }
    return;
  }
  if (PH == 2 || PH == 5 || PH == 7) {
    if (blockIdx.x >= (gridDim.x >> 1)) {
#pragma unroll 1
      for (int i_ = 0; i_ < 6; ++i_) __builtin_amdgcn_s_sleep(100);
    }
  }
  if (PH == 8) { p8_udots_all(p); return; }
  if (PH == 10) { p8_vacc_all(p, smem); return; }
  constexpr int n = PH == 0 ? P0_ITEMS : PH == 1 ? 1024 : PH == 2 ? 5120 : PH == 3 ? 4096 : PH == 4 ? 4096
                  : PH == 5 ? 2048 : PH == 6 ? 1024 : PH == 7 ? 4096 : PH == 8 ? 65536 : PH == 9 ? 2048
                  : PH == 10 ? 65536 : 2048;
  for (int v = blockIdx.x; v < n; v += gridDim.x) {
    if (PH == 0) phase0(p, v, smem);
    else if (PH == 1) p_norm_mod<false>(p.x, p.norm1_g, p.ada, 0, 1024, p.h, nullptr, nullptr, v);
    else if (PH == 2) p2_gemm1(p, xcd_swz(v, n), smem);
    else if (PH == 3) p3_mixer1(p, v, smem);
    else if (PH == 4) p4_mixer2(p, v, smem);
    else if (PH == 5) p5_gemm2(p, xcd_swz(v, n), smem);
    else if (PH == 6) p_norm_mod<true>(p.x1b, p.norm2_g, p.ada, 3072, 4096, p.h, p.h8, p.hS, v);
    else if (PH == 7) p7_route(p, xcd_swz(v, n), smem);
    else if (PH == 9) p8_coef(p, v);
    else p8_final(p, v);
  }
}

#if MULTI_LAUNCH
template <int PH> __global__ void __launch_bounds__(NT) k_phase(Params p) {
  extern __shared__ __attribute__((aligned(16))) char smem[];
  run_phase<PH>(p, smem);
}
#else
__global__ void __launch_bounds__(NT, 4) mega(Params p) {
  extern __shared__ __attribute__((aligned(16))) char smem[];
  cg::grid_group grid = cg::this_grid();
  volatile LAS unsigned* xst = (volatile LAS unsigned*)(smem + LDS_PHASE);
  if (threadIdx.x < 2) xst[threadIdx.x] = 0u;
  __syncthreads();
  const XcdBarrier xb = xcd_barrier_post(p.bar, xst);
  if (p.reps < 0) grid.sync();
#ifndef PROBE_PH
#define PROBE_PH -1
#endif
#define RUNPH(K, SYNC)                                                        \
  for (int r_ = 0; r_ < ((PROBE_PH == K) ? p.reps : 1); ++r_) {              \
    run_phase<K>(p, smem);                                                    \
    if (SYNC || PROBE_PH == K) xcd_barrier(xb);                               \
  }
  RUNPH(0, 1) RUNPH(1, 1) RUNPH(2, 1) RUNPH(3, 1) RUNPH(4, 1) RUNPH(5, 1) RUNPH(6, 1) RUNPH(7, 1) RUNPH(8, 1) RUNPH(9, 1) RUNPH(10, 1) RUNPH(11, 0)
}
#endif

extern "C" void kernel_launch(void* const* d_in, const int* in_sizes, int n_in, void* d_out, int out_size,
                              void* d_ws, size_t ws_size, hipStream_t stream) {
  Params p{};
  const float* const* in = (const float* const*)d_in;
  p.x = in[0]; p.c = in[1]; p.w_ada = in[2]; p.b_ada = in[3]; p.norm1_g = in[4]; p.w_in = in[5];
  p.conv_a_w = in[6]; p.conv_b_w = in[7]; p.conv_b_b = in[8]; p.w_r = in[9]; p.b_r = in[10];
  p.w_i = in[11]; p.b_i = in[12]; p.lam = in[13]; p.gn_a = in[14]; p.gn_b = in[15]; p.w_out = in[16];
  p.norm2_g = in[17]; p.w_q = in[18]; p.sub_keys = in[19]; p.expert_u = in[20]; p.expert_v = in[21];
  p.final_g = in[22];
  p.out = (float*)d_out;
  char* ws = (char*)d_ws;
  size_t off = 0;
  auto alloc = [&](size_t bytes) { void* r = ws + off; off += (bytes + 255) & ~(size_t)255; return r; };
  p.ada = (float*)alloc(8 * 6144 * 4);
  p.WinT = (u16*)alloc((size_t)2560 * 1024 * 2);
  p.WoutT = (u16*)alloc((size_t)1024 * 1024 * 2);
  p.WqT = (u16*)alloc((size_t)1024 * 1024 * 2);
  p.keysF = (u16*)alloc(131072 * 2);
  p.WrF = (u16*)alloc(32768 * 2);
  p.WiF = (u16*)alloc(32768 * 2);
  p.Ub = (unsigned char*)alloc((size_t)16384 * 1024);
  p.Vb = (unsigned char*)alloc((size_t)16384 * 1024);
  p.uS = (float*)alloc(16384 * 4);
  p.vS = (float*)alloc(16384 * 4);
  p.h = (u16*)alloc((size_t)T_ * 1024 * 2);
  p.z = (u16*)alloc((size_t)T_ * 2560 * 2);
  p.ycat = (u16*)alloc((size_t)T_ * 1024 * 2);
  p.hloc = (u16*)alloc((size_t)T_ * 512 * 2);
  p.logP = (u16*)alloc((size_t)T_ * 512 * 2);
  p.Hend = (float*)alloc(512 * 512 * 4);
  p.Pend = (float*)alloc(512 * 512 * 4);
  p.x1b = p.z;
  p.x2b = p.h;
  p.gsel = (float*)p.logP;
  p.Pd = p.ycat;
  p.coef16 = p.logP + (size_t)T_ * 128 * 2;
  p.idx16 = p.hloc;
  p.ssq = (float*)alloc((size_t)8 * T_ * 4);
  p.h8 = (signed char*)alloc((size_t)T_ * 1024);
  p.hS = (float*)alloc((size_t)T_ * 4);
  p.bar = (unsigned*)alloc(XCD_BAR_WORDS * 4);
  p.reps = 2; p.pad_ = 0;
#if MULTI_LAUNCH
  const int grid = 1024;
#define LAUNCH_PH(PH)                                                                              \
  hipFuncSetAttribute((const void*)k_phase<PH>, hipFuncAttributeMaxDynamicSharedMemorySize, LDS_BYTES); \
  k_phase<PH><<<grid, NT, LDS_BYTES, stream>>>(p);
  LAUNCH_PH(0) LAUNCH_PH(1) LAUNCH_PH(2) LAUNCH_PH(3) LAUNCH_PH(4)
  LAUNCH_PH(5) LAUNCH_PH(6) LAUNCH_PH(7) LAUNCH_PH(8) LAUNCH_PH(9) LAUNCH_PH(10) LAUNCH_PH(11)
#else
  static int grid_blocks = 0;
  hipFuncSetAttribute((const void*)mega, hipFuncAttributeMaxDynamicSharedMemorySize, LDS_BYTES);
  if (!grid_blocks) {
    int dev = 0, cus = 0, per_cu = 0;
    hipGetDevice(&dev);
    hipDeviceGetAttribute(&cus, hipDeviceAttributeMultiprocessorCount, dev);
    hipOccupancyMaxActiveBlocksPerMultiprocessor(&per_cu, mega, NT, LDS_BYTES);
    grid_blocks = cus * per_cu;
  }
  hipMemsetAsync(p.bar, 0, XCD_BAR_WORDS * 4, stream);
  void* args[] = {&p};
  hipError_t e = hipLaunchCooperativeKernel((void*)mega, dim3(grid_blocks), dim3(NT), args, LDS_BYTES, stream);
  if (e != hipSuccess) fprintf(stderr, "cooperative launch failed: %s (grid %d)\n", hipGetErrorString(e), grid_blocks);
#endif
}
```

```cpp
#include <hip/hip_runtime.h>
#include <hip/hip_cooperative_groups.h>
#include <cstdio>
namespace cg = cooperative_groups;

#ifndef MULTI_LAUNCH
#define MULTI_LAUNCH 0
#endif

typedef unsigned short u16;
using bf16x8 = __attribute__((ext_vector_type(8))) short;
using f32x16 = __attribute__((ext_vector_type(16))) float;

#define DEV __device__ __forceinline__
DEV int tidx() { int t = threadIdx.x; asm volatile("" : "+v"(t)); return t; }

constexpr int NT = 512;
constexpr int T_ = 65536;
constexpr int LDS_PHASE = 73728;
constexpr int LDS_BYTES = LDS_PHASE + 16;
constexpr int LROW = 144;
constexpr int STAGE = 256 * LROW;

struct Params {
  const float *x, *c, *w_ada, *b_ada, *norm1_g, *w_in, *conv_a_w, *conv_b_w, *conv_b_b;
  const float *w_r, *b_r, *w_i, *b_i, *lam, *gn_a, *gn_b, *w_out, *norm2_g, *w_q, *sub_keys;
  const float *expert_u, *expert_v, *final_g;
  float* out;
  float* ada;
  u16 *WinT, *WoutT, *WqT;
  u16 *keysF, *WrF, *WiF;
  unsigned char *Ub, *Vb;
  float *uS, *vS;
  u16 *h;
  u16 *z;
  u16 *ycat;
  u16 *hloc, *logP;
  float *Hend, *Pend;
  u16 *x1b;
  u16 *x2b;
  float* gsel;
  unsigned short* Pd;
  unsigned short* coef16;
  unsigned short* idx16;
  signed char* h8;
  float* hS;
  float* ssq;
  unsigned* bar;
  int reps; int pad_;
};

DEV u16 f2bf(float f) {
  unsigned u = __float_as_uint(f);
  u += 0x7FFFu + ((u >> 16) & 1u);
  return (u16)(u >> 16);
}
DEV float bf2f(u16 h) { return __uint_as_float(((unsigned)h) << 16); }
DEV unsigned pack2(float a, float b) { return (unsigned)f2bf(a) | ((unsigned)f2bf(b) << 16); }
DEV void unpack8(uint4 v, float* f) {
  f[0] = __uint_as_float(v.x << 16); f[1] = __uint_as_float(v.x & 0xFFFF0000u);
  f[2] = __uint_as_float(v.y << 16); f[3] = __uint_as_float(v.y & 0xFFFF0000u);
  f[4] = __uint_as_float(v.z << 16); f[5] = __uint_as_float(v.z & 0xFFFF0000u);
  f[6] = __uint_as_float(v.w << 16); f[7] = __uint_as_float(v.w & 0xFFFF0000u);
}
DEV unsigned pack_i8x4(float a, float b, float c, float d) {
  const int qa = (int)rintf(fminf(fmaxf(a, -127.f), 127.f)), qb = (int)rintf(fminf(fmaxf(b, -127.f), 127.f));
  const int qc = (int)rintf(fminf(fmaxf(c, -127.f), 127.f)), qd = (int)rintf(fminf(fmaxf(d, -127.f), 127.f));
  return (unsigned)(qa & 0xFF) | ((unsigned)(qb & 0xFF) << 8) | ((unsigned)(qc & 0xFF) << 16) | ((unsigned)(qd & 0xFF) << 24);
}
DEV float sigm(float x) { return 1.f / (1.f + __expf(-x)); }
DEV float gelu_tanh(float x) {
  float u = 0.7978845608028654f * (x + 0.044715f * x * x * x);
  float t = 1.f - 2.f / (1.f + __expf(2.f * u));
  return 0.5f * x * (1.f + t);
}
DEV float wave_allsum(float v) {
#pragma unroll
  for (int o = 32; o > 0; o >>= 1) v += __shfl_xor(v, o, 64);
  return v;
}
template <int CTRL> DEV unsigned dpp_u(unsigned v) {
  return (unsigned)__builtin_amdgcn_update_dpp((int)v, (int)v, CTRL, 0xF, 0xF, true);
}
DEV unsigned row_max_u(unsigned v) {
  v = max(v, dpp_u<0xB1>(v));
  v = max(v, dpp_u<0x4E>(v));
  v = max(v, dpp_u<0x141>(v));
  v = max(v, dpp_u<0x140>(v));
  return v;
}
DEV float row_sum_f(float v) {
  v += __uint_as_float(dpp_u<0xB1>(__float_as_uint(v)));
  v += __uint_as_float(dpp_u<0x4E>(__float_as_uint(v)));
  v += __uint_as_float(dpp_u<0x141>(__float_as_uint(v)));
  v += __uint_as_float(dpp_u<0x140>(__float_as_uint(v)));
  return v;
}
DEV unsigned sortable(float f) {
  unsigned k = __float_as_uint(f);
  return (k & 0x80000000u) ? ~k : (k | 0x80000000u);
}
DEV float unsortable(unsigned k) {
  return __uint_as_float((k & 0x80000000u) ? (k & 0x7FFFFFFFu) : ~k);
}
DEV f32x16 mfma32(bf16x8 a, bf16x8 b, f32x16 c) {
  return __builtin_amdgcn_mfma_f32_32x32x16_bf16(a, b, c, 0, 0, 0);
}
DEV int crow(int reg, int lane) { return (reg & 3) + 8 * (reg >> 2) + 4 * (lane >> 5); }

DEV void p0_ada(const Params& p, int item, char* smem) {
  float* sRed = (float*)smem;
  float* sC = (float*)(smem + 16384);
  const int tid = tidx(), w = tid >> 6, lane = tid & 63;
  const int col = item * 64 + lane;
#pragma unroll
  for (int i = 0; i < 16; ++i) {
    const int e = lane + 64 * i, b = e >> 7, kk = e & 127;
    const float cv = p.c[b * 1024 + w * 128 + kk];
    sC[w * 1024 + e] = cv / (1.f + __expf(-cv));
  }
  __syncthreads();
  float acc[8];
#pragma unroll
  for (int b = 0; b < 8; ++b) acc[b] = 0.f;
  const float* wp = p.w_ada + (size_t)(w * 128) * 6144 + col;
  const float* sc = sC + w * 1024;
#pragma unroll 64
  for (int kk = 0; kk < 128; ++kk) {
    const float wv = wp[(size_t)kk * 6144];
#pragma unroll
    for (int b = 0; b < 8; ++b) acc[b] += sc[b * 128 + kk] * wv;
  }
#pragma unroll
  for (int b = 0; b < 8; ++b) sRed[(w * 8 + b) * 64 + lane] = acc[b];
  __syncthreads();
  {
    const int b = tid >> 6, cl = tid & 63;
    float sum = 0.f;
#pragma unroll
    for (int w2 = 0; w2 < 8; ++w2) sum += sRed[(w2 * 8 + b) * 64 + cl];
    p.ada[b * 6144 + item * 64 + cl] = sum + p.b_ada[item * 64 + cl];
  }
  __syncthreads();
}

DEV void p0_transpose(const float* W, int K, int N, u16* Wt, int item, char* smem) {
  float* sT = (float*)smem;
  const int ntn = N >> 6;
  const int nt = item % ntn, kt = item / ntn;
  const int tid = tidx();
#pragma unroll
  for (int i = 0; i < 8; ++i) {
    const int e = tid + i * NT, r = e >> 6, c = e & 63;
    sT[r * 65 + c] = W[(size_t)(kt * 64 + r) * N + nt * 64 + c];
  }
  __syncthreads();
#pragma unroll
  for (int i = 0; i < 8; ++i) {
    const int e = tid + i * NT, r = e >> 6, c = e & 63;
    Wt[(size_t)(nt * 64 + r) * K + kt * 64 + c] = f2bf(sT[c * 65 + r]);
  }
  __syncthreads();
}

DEV void p0_keys(const Params& p, int item) {
#pragma unroll
  for (int i = 0; i < 8; ++i) {
    const int o = item * 4096 + i * NT + tidx();
    const int j = o & 7, lane = (o >> 3) & 63, kk = (o >> 9) & 3, nt = (o >> 11) & 3, hc = o >> 13;
    const int n = nt * 32 + (lane & 31), k = kk * 16 + (lane >> 5) * 8 + j;
    p.keysF[o] = f2bf(p.sub_keys[(hc * 128 + n) * 64 + k]);
  }
}
DEV void p0_gate(const float* W, u16* WF, int item) {
#pragma unroll
  for (int i = 0; i < 8; ++i) {
    const int o = item * 4096 + i * NT + tidx();
    const int j = o & 7, lane = (o >> 3) & 63, kk = (o >> 9) & 3, nt = (o >> 11) & 1, hh = o >> 12;
    const int n = nt * 32 + (lane & 31), k = kk * 16 + (lane >> 5) * 8 + j;
    WF[o] = f2bf(W[(hh * 64 + k) * 64 + n]);
  }
}
DEV void p0_expert(const float* src, unsigned char* dst, float* scl, int item) {
  const int lane = tidx() & 63, w = tidx() >> 6;
  const size_t e = (size_t)item * 8 + w;
  const float* rp = src + e * 1024 + lane * 16;
  float4 v[4];
  float am = 0.f;
#pragma unroll
  for (int i = 0; i < 4; ++i) {
    v[i] = *(const float4*)(rp + i * 4);
    am = fmaxf(am, fmaxf(fmaxf(fabsf(v[i].x), fabsf(v[i].y)), fmaxf(fabsf(v[i].z), fabsf(v[i].w))));
  }
#pragma unroll
  for (int o = 32; o > 0; o >>= 1) am = fmaxf(am, __shfl_xor(am, o, 64));
  am = fmaxf(am, 1e-30f);
  const float sc = 448.f / am;
  unsigned q[4];
#pragma unroll
  for (int i = 0; i < 4; ++i) {
    int t = __builtin_amdgcn_cvt_pk_fp8_f32(v[i].x * sc, v[i].y * sc, 0, false);
    t = __builtin_amdgcn_cvt_pk_fp8_f32(v[i].z * sc, v[i].w * sc, t, true);
    q[i] = (unsigned)t;
  }
  *(uint4*)(dst + (size_t)(lane >> 3) * (16384 * 128) + e * 128 + (lane & 7) * 16) = make_uint4(q[0], q[1], q[2], q[3]);
  if (lane == 0) scl[e] = am * (1.f / 448.f);
}
DEV void p0_expert_i8(const float* src, unsigned char* dst, float* scl, int item) {
  const int lane = tidx() & 63, w = tidx() >> 6;
  const size_t e = (size_t)item * 8 + w;
  const float* rp = src + e * 1024 + lane * 16;
  float4 v[4];
  float am = 0.f;
#pragma unroll
  for (int i = 0; i < 4; ++i) {
    v[i] = *(const float4*)(rp + i * 4);
    am = fmaxf(am, fmaxf(fmaxf(fabsf(v[i].x), fabsf(v[i].y)), fmaxf(fabsf(v[i].z), fabsf(v[i].w))));
  }
#pragma unroll
  for (int o = 32; o > 0; o >>= 1) am = fmaxf(am, __shfl_xor(am, o, 64));
  am = fmaxf(am, 1e-30f);
  const float sc = 127.f / am;
  unsigned q[4];
#pragma unroll
  for (int i = 0; i < 4; ++i) q[i] = pack_i8x4(v[i].x * sc, v[i].y * sc, v[i].z * sc, v[i].w * sc);
  *(uint4*)(dst + (size_t)(lane >> 3) * (16384 * 128) + e * 128 + (lane & 7) * 16) = make_uint4(q[0], q[1], q[2], q[3]);
  if (lane == 0) scl[e] = am * (1.f / 127.f);
}
constexpr int P0_ITEMS = 96 + 640 + 256 + 256 + 32 + 8 + 8 + 2048 + 2048;
DEV void phase0(const Params& p, int item, char* smem) {
  if (item < 96) { p0_ada(p, item, smem); return; }
  item -= 96;
  if (item < 640) { p0_transpose(p.w_in, 1024, 2560, p.WinT, item, smem); return; }
  item -= 640;
  if (item < 256) { p0_transpose(p.w_out, 1024, 1024, p.WoutT, item, smem); return; }
  item -= 256;
  if (item < 256) { p0_transpose(p.w_q, 1024, 1024, p.WqT, item, smem); return; }
  item -= 256;
  if (item < 32) { p0_keys(p, item); return; }
  item -= 32;
  if (item < 8) { p0_gate(p.w_r, p.WrF, item); return; }
  item -= 8;
  if (item < 8) { p0_gate(p.w_i, p.WiF, item); return; }
  item -= 8;
  if (item < 2048) { p0_expert_i8(p.expert_u, p.Ub, p.uS, item); return; }
  item -= 2048;
  p0_expert(p.expert_v, p.Vb, p.vS, item);
}

template <bool BF> DEV void p_norm_mod(const void* xin_, const float* g, const float* ada, int sh_off, int sc_off,
                    u16* hout, signed char* h8out, float* hSout, int item) {
  const int tid = tidx(), lane = tid & 63, w = tid >> 6;
  const int t0 = item * 64 + w * 8;
  const int b = t0 >> 13;
  float4 gg[4], sc[4], sh[4];
#pragma unroll
  for (int i = 0; i < 4; ++i) {
    gg[i] = *(const float4*)(g + i * 256 + lane * 4);
    sc[i] = *(const float4*)(ada + b * 6144 + sc_off + i * 256 + lane * 4);
    sh[i] = *(const float4*)(ada + b * 6144 + sh_off + i * 256 + lane * 4);
    gg[i].x *= (1.f + sc[i].x); gg[i].y *= (1.f + sc[i].y); gg[i].z *= (1.f + sc[i].z); gg[i].w *= (1.f + sc[i].w);
  }
#pragma unroll 2
  for (int tt = 0; tt < 8; ++tt) {
    const size_t t = t0 + tt;
    float4 xv[4];
    float ss = 0.f;
#pragma unroll
    for (int i = 0; i < 4; ++i) {
      if (BF) {
        const uint2 r2 = *(const uint2*)((const u16*)xin_ + t * 1024 + i * 256 + lane * 4);
        xv[i] = make_float4(__uint_as_float(r2.x << 16), __uint_as_float(r2.x & 0xFFFF0000u),
                            __uint_as_float(r2.y << 16), __uint_as_float(r2.y & 0xFFFF0000u));
      } else {
        xv[i] = *(const float4*)((const float*)xin_ + t * 1024 + i * 256 + lane * 4);
      }
      ss += xv[i].x * xv[i].x + xv[i].y * xv[i].y + xv[i].z * xv[i].z + xv[i].w * xv[i].w;
    }
    ss = wave_allsum(ss);
    const float rstd = rsqrtf(ss * (1.f / 1024.f) + 1e-6f);
    float am = 0.f;
#pragma unroll
    for (int i = 0; i < 4; ++i) {
      xv[i].x = xv[i].x * rstd * gg[i].x + sh[i].x; xv[i].y = xv[i].y * rstd * gg[i].y + sh[i].y;
      xv[i].z = xv[i].z * rstd * gg[i].z + sh[i].z; xv[i].w = xv[i].w * rstd * gg[i].w + sh[i].w;
      uint2 o;
      o.x = pack2(xv[i].x, xv[i].y);
      o.y = pack2(xv[i].z, xv[i].w);
      *(uint2*)(hout + t * 1024 + i * 256 + lane * 4) = o;
      if (BF) am = fmaxf(am, fmaxf(fmaxf(fabsf(xv[i].x), fabsf(xv[i].y)), fmaxf(fabsf(xv[i].z), fabsf(xv[i].w))));
    }
    if (BF) {
#pragma unroll
      for (int o = 32; o > 0; o >>= 1) am = fmaxf(am, __shfl_xor(am, o, 64));
      am = fmaxf(am, 1e-30f);
      const float qs = 127.f / am;
#pragma unroll
      for (int i = 0; i < 4; ++i)
        *(unsigned*)(h8out + t * 1024 + i * 256 + lane * 4) = pack_i8x4(xv[i].x * qs, xv[i].y * qs, xv[i].z * qs, xv[i].w * qs);
      if (lane == 0) hSout[t] = am * (1.f / 127.f);
    }
  }
}

DEV void gemm_core(const u16* __restrict__ A, const u16* __restrict__ Bt, int m0, int n0, char* smem,
                   f32x16& acc0, f32x16& acc1) {
  const int tid = tidx(), lane = tid & 63, w = tid >> 6, wr = w >> 1, wc = w & 1;
  const int lrow = tid >> 3, lc = tid & 7;
  const u16* ga = A + (size_t)(m0 + lrow) * 1024 + lc * 8;
  const u16* gb = Bt + (size_t)(n0 + lrow) * 1024 + lc * 8;
  const int lw = lrow * LROW + lc * 16;
  uint4 pa0, pa1, pb0, pb1, qa0, qa1, qb0, qb1;
  {
    const uint4 ra0 = *(const uint4*)ga, ra1 = *(const uint4*)(ga + 64 * 1024);
    const uint4 rb0 = *(const uint4*)gb, rb1 = *(const uint4*)(gb + 64 * 1024);
    __builtin_amdgcn_sched_barrier(0);
    pa0 = *(const uint4*)(ga + 64); pa1 = *(const uint4*)(ga + 64 * 1024 + 64);
    pb0 = *(const uint4*)(gb + 64); pb1 = *(const uint4*)(gb + 64 * 1024 + 64);
    __builtin_amdgcn_sched_barrier(0);
    qa0 = *(const uint4*)(ga + 128); qa1 = *(const uint4*)(ga + 64 * 1024 + 128);
    qb0 = *(const uint4*)(gb + 128); qb1 = *(const uint4*)(gb + 64 * 1024 + 128);
    __builtin_amdgcn_sched_barrier(0);
    *(uint4*)(smem + lw) = ra0;
    *(uint4*)(smem + lw + 64 * LROW) = ra1;
    *(uint4*)(smem + lw + 128 * LROW) = rb0;
    *(uint4*)(smem + lw + 192 * LROW) = rb1;
  }
  __syncthreads();
  const int a_off = (wr * 32 + (lane & 31)) * LROW + (lane >> 5) * 16;
  const int b_off = (128 + wc * 64 + (lane & 31)) * LROW + (lane >> 5) * 16;
#define GC128_COMPUTE(CUR)                                                              \
  _Pragma("unroll") for (int kk = 0; kk < 4; ++kk) {                                    \
    const bf16x8 a = *(const bf16x8*)((CUR) + a_off + kk * 32);                         \
    const bf16x8 b0 = *(const bf16x8*)((CUR) + b_off + kk * 32);                        \
    const bf16x8 b1 = *(const bf16x8*)((CUR) + b_off + 32 * LROW + kk * 32);            \
    acc0 = mfma32(a, b0, acc0);                                                         \
    acc1 = mfma32(a, b1, acc1);                                                         \
  }
#pragma unroll 1
  for (int kt = 0; kt < 16; kt += 2) {
    char* buf0 = smem;
    char* buf1 = smem + STAGE;
    GC128_COMPUTE(buf0)
    {
      *(uint4*)(buf1 + lw) = pa0;
      *(uint4*)(buf1 + lw + 64 * LROW) = pa1;
      *(uint4*)(buf1 + lw + 128 * LROW) = pb0;
      *(uint4*)(buf1 + lw + 192 * LROW) = pb1;
    }
    {
      const int ko = min(kt + 3, 15) * 64;
      pa0 = *(const uint4*)(ga + ko); pa1 = *(const uint4*)(ga + 64 * 1024 + ko);
      pb0 = *(const uint4*)(gb + ko); pb1 = *(const uint4*)(gb + 64 * 1024 + ko);
    }
    __syncthreads();
    GC128_COMPUTE(buf1)
    {
      *(uint4*)(buf0 + lw) = qa0;
      *(uint4*)(buf0 + lw + 64 * LROW) = qa1;
      *(uint4*)(buf0 + lw + 128 * LROW) = qb0;
      *(uint4*)(buf0 + lw + 192 * LROW) = qb1;
    }
    {
      const int ko = min(kt + 4, 15) * 64;
      qa0 = *(const uint4*)(ga + ko); qa1 = *(const uint4*)(ga + 64 * 1024 + ko);
      qb0 = *(const uint4*)(gb + ko); qb1 = *(const uint4*)(gb + 64 * 1024 + ko);
    }
    __syncthreads();
  }
#undef GC128_COMPUTE
}
DEV f32x16 zero16() {
  f32x16 z;
#pragma unroll
  for (int i = 0; i < 16; ++i) z[i] = 0.f;
  return z;
}

constexpr int LROW2 = 80;
constexpr int STAGE2 = 384 * LROW2;
DEV void gemm_core256(const u16* __restrict__ A, const u16* __restrict__ Bt, int m0, int n0, char* smem,
                      f32x16 (&acc)[2][2]) {
  const int tid = tidx(), lane = tid & 63, w = tid >> 6, wr = w >> 1, wc = w & 1;
  const int lrow = tid >> 2, lc = tid & 3;
  const u16* ga = A + (size_t)(m0 + lrow) * 1024 + lc * 8;
  const u16* gb = Bt + (size_t)(n0 + lrow) * 1024 + lc * 8;
  const int lw = lrow * LROW2 + lc * 16;
  uint4 pa0, pa1, pb0, qa0, qa1, qb0;
  {
    const uint4 ra0 = *(const uint4*)ga, ra1 = *(const uint4*)(ga + 128 * 1024), rb0 = *(const uint4*)gb;
    __builtin_amdgcn_sched_barrier(0);
    pa0 = *(const uint4*)(ga + 32); pa1 = *(const uint4*)(ga + 128 * 1024 + 32); pb0 = *(const uint4*)(gb + 32);
    __builtin_amdgcn_sched_barrier(0);
    qa0 = *(const uint4*)(ga + 64); qa1 = *(const uint4*)(ga + 128 * 1024 + 64); qb0 = *(const uint4*)(gb + 64);
    __builtin_amdgcn_sched_barrier(0);
    *(uint4*)(smem + lw) = ra0;
    *(uint4*)(smem + lw + 128 * LROW2) = ra1;
    *(uint4*)(smem + lw + 256 * LROW2) = rb0;
  }
  __syncthreads();
  const int a_off = (wr * 64 + (lane & 31)) * LROW2 + (lane >> 5) * 16;
  const int b_off = (256 + wc * 64 + (lane & 31)) * LROW2 + (lane >> 5) * 16;
#define GC256_COMPUTE(CUR)                                                              \
  _Pragma("unroll") for (int kk = 0; kk < 2; ++kk) {                                    \
    const bf16x8 a0 = *(const bf16x8*)((CUR) + a_off + kk * 32);                        \
    const bf16x8 a1 = *(const bf16x8*)((CUR) + a_off + 32 * LROW2 + kk * 32);           \
    const bf16x8 b0 = *(const bf16x8*)((CUR) + b_off + kk * 32);                        \
    const bf16x8 b1 = *(const bf16x8*)((CUR) + b_off + 32 * LROW2 + kk * 32);           \
    acc[0][0] = mfma32(a0, b0, acc[0][0]);                                              \
    acc[0][1] = mfma32(a0, b1, acc[0][1]);                                              \
    acc[1][0] = mfma32(a1, b0, acc[1][0]);                                              \
    acc[1][1] = mfma32(a1, b1, acc[1][1]);                                              \
  }
#pragma unroll 1
  for (int kt = 0; kt < 32; kt += 2) {
    char* buf0 = smem;
    char* buf1 = smem + STAGE2;
    GC256_COMPUTE(buf0)
    {
      *(uint4*)(buf1 + lw) = pa0;
      *(uint4*)(buf1 + lw + 128 * LROW2) = pa1;
      *(uint4*)(buf1 + lw + 256 * LROW2) = pb0;
    }
    {
      const int ko = min(kt + 3, 31) * 32;
      pa0 = *(const uint4*)(ga + ko); pa1 = *(const uint4*)(ga + 128 * 1024 + ko); pb0 = *(const uint4*)(gb + ko);
    }
    __syncthreads();
    GC256_COMPUTE(buf1)
    {
      *(uint4*)(buf0 + lw) = qa0;
      *(uint4*)(buf0 + lw + 128 * LROW2) = qa1;
      *(uint4*)(buf0 + lw + 256 * LROW2) = qb0;
    }
    {
      const int ko = min(kt + 4, 31) * 32;
      qa0 = *(const uint4*)(ga + ko); qa1 = *(const uint4*)(ga + 128 * 1024 + ko); qb0 = *(const uint4*)(gb + ko);
    }
    __syncthreads();
  }
#undef GC256_COMPUTE
}
DEV void stage_acc256(char* smem, const f32x16 (&acc)[2][2], int half) {
  float* sO = (float*)smem;
  const int tid = tidx(), lane = tid & 63, w = tid >> 6, wr = w >> 1, wc = w & 1;
  if ((wr >> 1) == half) {
    const int rb = (wr & 1) * 64, cb = wc * 64 + (lane & 31);
#pragma unroll
    for (int mi = 0; mi < 2; ++mi)
#pragma unroll
      for (int r = 0; r < 16; ++r) {
        const int row = rb + mi * 32 + crow(r, lane);
        sO[row * 132 + cb] = acc[mi][0][r];
        sO[row * 132 + cb + 32] = acc[mi][1][r];
      }
  }
  __syncthreads();
}
DEV void p2_gemm1(const Params& p, int item, char* smem) {
  const int xq = item / 640, j = item % 640;
  const int gid = j / 160, r = j % 160;
  const int mt = xq * 32 + gid * 8 + (r & 7), nt = r >> 3;
  f32x16 acc[2][2] = {{zero16(), zero16()}, {zero16(), zero16()}};
  gemm_core256(p.h, p.WinT, mt * 256, nt * 128, smem, acc);
  const float* sO = (const float*)smem;
  const int tid = tidx();
#pragma unroll
  for (int half = 0; half < 2; ++half) {
    stage_acc256(smem, acc, half);
#pragma unroll
    for (int i = 0; i < 4; ++i) {
      const int q = tid + i * NT, row = q >> 4, c8 = q & 15;
      const float4 a = *(const float4*)(sO + row * 132 + c8 * 8);
      const float4 b = *(const float4*)(sO + row * 132 + c8 * 8 + 4);
      *(uint4*)(p.z + (size_t)(mt * 256 + half * 128 + row) * 2560 + nt * 128 + c8 * 8) =
          make_uint4(pack2(a.x, a.y), pack2(a.z, a.w), pack2(b.x, b.y), pack2(b.z, b.w));
    }
    __syncthreads();
  }
}
DEV void p5_gemm2(const Params& p, int item, char* smem) {
  const int mt = item >> 3, nt = item & 7;
  f32x16 acc[2][2] = {{zero16(), zero16()}, {zero16(), zero16()}};
  gemm_core256(p.ycat, p.WoutT, mt * 256, nt * 128, smem, acc);
  const float* sO = (const float*)smem;
  const int tid = tidx();
  const int b = (mt * 256) >> 13;
  const int row0 = tid >> 4, c8 = tid & 15;
  const float* gp = p.ada + b * 6144 + 2048 + nt * 128 + c8 * 8;
  const float4 g0 = *(const float4*)gp, g1 = *(const float4*)(gp + 4);
#pragma unroll
  for (int half = 0; half < 2; ++half) {
    const float* xp = p.x + (size_t)(mt * 256 + half * 128 + row0) * 1024 + nt * 128 + c8 * 8;
    u16* op = p.x1b + (size_t)(mt * 256 + half * 128 + row0) * 1024 + nt * 128 + c8 * 8;
    float4 xa0 = *(const float4*)xp, xb0 = *(const float4*)(xp + 4);
    float4 xa1 = *(const float4*)(xp + 32 * 1024), xb1 = *(const float4*)(xp + 32 * 1024 + 4);
    stage_acc256(smem, acc, half);
    const float4 xa2 = *(const float4*)(xp + 64 * 1024), xb2 = *(const float4*)(xp + 64 * 1024 + 4);
    const float4 xa3 = *(const float4*)(xp + 96 * 1024), xb3 = *(const float4*)(xp + 96 * 1024 + 4);
#define P5_OUT(I, XA, XB) {                                                                                         \
      const float4 a0 = *(const float4*)(sO + (row0 + 32 * I) * 132 + c8 * 8);                                       \
      const float4 a1 = *(const float4*)(sO + (row0 + 32 * I) * 132 + c8 * 8 + 4);                                   \
      *(uint4*)(op + (size_t)(32 * I) * 1024) =                                                                      \
          make_uint4(pack2(XA.x + g0.x * a0.x, XA.y + g0.y * a0.y), pack2(XA.z + g0.z * a0.z, XA.w + g0.w * a0.w),    \
                     pack2(XB.x + g1.x * a1.x, XB.y + g1.y * a1.y), pack2(XB.z + g1.z * a1.z, XB.w + g1.w * a1.w)); }
    P5_OUT(0, xa0, xb0) P5_OUT(1, xa1, xb1) P5_OUT(2, xa2, xb2) P5_OUT(3, xa3, xb3)
#undef P5_OUT
    __syncthreads();
  }
}

constexpr int P3_WOFF = 71008;
DEV void p3_stage_head(const Params& p, int h, char* smem) {
  float* sWt = (float*)(smem + P3_WOFF);
  const int tid = tidx();
  __syncthreads();
  for (int e = tid; e < 9 * 64; e += NT) {
    const int r = e >> 6, c = e & 63;
    float v;
    if (r < 3) v = p.conv_a_w[r * 512 + h * 64 + c];
    else if (r < 7) v = p.conv_b_w[(r - 3) * 512 + h * 64 + c];
    else if (r == 7) v = p.conv_b_b[h * 64 + c];
    else v = p.gn_a[h * 64 + c];
    sWt[e] = v;
  }
  __syncthreads();
}
DEV void p3_mixer1(const Params& p, int item, char* smem) {
  const int tid = tidx(), lane = tid & 63, w = tid >> 6;
  const int tile = item >> 3, h = item & 7;
  const int t0 = tile * 128;
  const int tb = t0 & 8191;
  const float* sWt = (const float*)(smem + P3_WOFF);
  const uint4 ld_gb0 = *(const uint4*)(p.z + ((size_t)t0 + (tid >> 2)) * 2560 + h * 64 + (tid & 3) * 16);
  const uint4 ld_gb1 = *(const uint4*)(p.z + ((size_t)t0 + (tid >> 2)) * 2560 + h * 64 + (tid & 3) * 16 + 8);
  const int hc_e = h * 64 + (w & 1) * 32 + (lane & 31);
  const float ld_br = p.b_r[hc_e], ld_bi = p.b_i[hc_e], ld_lam = p.lam[hc_e];
  float* sXr = (float*)smem;
  float* sCx = (float*)(smem + 131 * 68 * 4);
  for (int q = tid; q < 131 * 8; q += NT) {
    const int r = q >> 3, c8 = q & 7;
    float f[8];
    if (tb + r - 3 >= 0) {
      const uint4 v = *(const uint4*)(p.z + (size_t)(t0 + r - 3) * 2560 + 1536 + h * 64 + c8 * 8);
      unpack8(v, f);
    } else {
#pragma unroll
      for (int j = 0; j < 8; ++j) f[j] = 0.f;
    }
    *(float4*)(sXr + r * 68 + c8 * 8) = make_float4(f[0], f[1], f[2], f[3]);
    *(float4*)(sXr + r * 68 + c8 * 8 + 4) = make_float4(f[4], f[5], f[6], f[7]);
  }
  for (int q = tid; q < 130 * 8; q += NT) {
    const int r = q >> 3, c8 = q & 7;
    float f[8], g[8];
    if (tb + r - 2 >= 0) {
      const u16* zr = p.z + (size_t)(t0 + r - 2) * 2560 + h * 64 + c8 * 8;
      const uint4 v = *(const uint4*)(zr + 512);
      const uint4 v2 = *(const uint4*)(zr + 1024);
      unpack8(v, f); unpack8(v2, g);
#pragma unroll
      for (int j = 0; j < 8; ++j) f[j] *= g[j];
    } else {
#pragma unroll
      for (int j = 0; j < 8; ++j) f[j] = 0.f;
    }
    *(float4*)(sCx + r * 68 + c8 * 8) = make_float4(f[0], f[1], f[2], f[3]);
    *(float4*)(sCx + r * 68 + c8 * 8 + 4) = make_float4(f[4], f[5], f[6], f[7]);
  }
  __syncthreads();
  const int tl = tid >> 2, q4 = tid & 3;
  const size_t t = (size_t)t0 + tl;
  const int cb = h * 64 + q4 * 16;
  {
    float gb[16], ya[16];
    unpack8(ld_gb0, gb);
    unpack8(ld_gb1, gb + 8);
    float ss = 0.f;
#pragma unroll
    for (int c4 = 0; c4 < 4; ++c4) {
      const float4 w0 = *(const float4*)(sWt + 0 * 64 + q4 * 16 + c4 * 4);
      const float4 w1 = *(const float4*)(sWt + 1 * 64 + q4 * 16 + c4 * 4);
      const float4 w2 = *(const float4*)(sWt + 2 * 64 + q4 * 16 + c4 * 4);
      const float4 x0 = *(const float4*)(sCx + (tl + 0) * 68 + q4 * 16 + c4 * 4);
      const float4 x1 = *(const float4*)(sCx + (tl + 1) * 68 + q4 * 16 + c4 * 4);
      const float4 x2 = *(const float4*)(sCx + (tl + 2) * 68 + q4 * 16 + c4 * 4);
      ya[c4 * 4 + 0] = gb[c4 * 4 + 0] * (w0.x * x0.x + w1.x * x1.x + w2.x * x2.x);
      ya[c4 * 4 + 1] = gb[c4 * 4 + 1] * (w0.y * x0.y + w1.y * x1.y + w2.y * x2.y);
      ya[c4 * 4 + 2] = gb[c4 * 4 + 2] * (w0.z * x0.z + w1.z * x1.z + w2.z * x2.z);
      ya[c4 * 4 + 3] = gb[c4 * 4 + 3] * (w0.w * x0.w + w1.w * x1.w + w2.w * x2.w);
      asm volatile("" ::: "memory");
    }
#pragma unroll
    for (int c = 0; c < 16; ++c) ss += ya[c] * ya[c];
    ss += __shfl_xor(ss, 1, 64);
    ss += __shfl_xor(ss, 2, 64);
    const float rstd = rsqrtf(ss * (1.f / 64.f) + 1e-6f);
    unsigned o[8];
#pragma unroll
    for (int c2 = 0; c2 < 8; ++c2)
      o[c2] = pack2(ya[c2 * 2] * rstd * sWt[8 * 64 + q4 * 16 + c2 * 2], ya[c2 * 2 + 1] * rstd * sWt[8 * 64 + q4 * 16 + c2 * 2 + 1]);
    *(uint4*)(p.ycat + t * 1024 + cb) = make_uint4(o[0], o[1], o[2], o[3]);
    *(uint4*)(p.ycat + t * 1024 + cb + 8) = make_uint4(o[4], o[5], o[6], o[7]);
  }
  unsigned xp[8];
#pragma unroll
  for (int c4 = 0; c4 < 4; ++c4) {
    const float4 w0 = *(const float4*)(sWt + 3 * 64 + q4 * 16 + c4 * 4);
    const float4 w1 = *(const float4*)(sWt + 4 * 64 + q4 * 16 + c4 * 4);
    const float4 w2 = *(const float4*)(sWt + 5 * 64 + q4 * 16 + c4 * 4);
    const float4 w3 = *(const float4*)(sWt + 6 * 64 + q4 * 16 + c4 * 4);
    const float4 bb = *(const float4*)(sWt + 7 * 64 + q4 * 16 + c4 * 4);
    const float4 x0 = *(const float4*)(sXr + (tl + 0) * 68 + q4 * 16 + c4 * 4);
    const float4 x1 = *(const float4*)(sXr + (tl + 1) * 68 + q4 * 16 + c4 * 4);
    const float4 x2 = *(const float4*)(sXr + (tl + 2) * 68 + q4 * 16 + c4 * 4);
    const float4 x3 = *(const float4*)(sXr + (tl + 3) * 68 + q4 * 16 + c4 * 4);
    const float vx = w0.x * x0.x + w1.x * x1.x + w2.x * x2.x + w3.x * x3.x + bb.x;
    const float vy = w0.y * x0.y + w1.y * x1.y + w2.y * x2.y + w3.y * x3.y + bb.y;
    const float vz = w0.z * x0.z + w1.z * x1.z + w2.z * x2.z + w3.z * x3.z + bb.z;
    const float vw = w0.w * x0.w + w1.w * x1.w + w2.w * x2.w + w3.w * x3.w + bb.w;
    xp[c4 * 2] = pack2(vx, vy); xp[c4 * 2 + 1] = pack2(vz, vw);
    asm volatile("" ::: "memory");
  }
  __syncthreads();
  u16* sXp = (u16*)smem;
  *(uint4*)(smem + tl * 144 + q4 * 32) = make_uint4(xp[0], xp[1], xp[2], xp[3]);
  *(uint4*)(smem + tl * 144 + q4 * 32 + 16) = make_uint4(xp[4], xp[5], xp[6], xp[7]);
  __syncthreads();
  const int mt = w >> 1, nt = w & 1;
  f32x16 accR = zero16(), accI = zero16();
#pragma unroll
  for (int kk = 0; kk < 4; ++kk) {
    const bf16x8 a = *(const bf16x8*)(smem + (mt * 32 + (lane & 31)) * 144 + kk * 32 + (lane >> 5) * 16);
    const size_t fo = (size_t)((((h * 2 + nt) * 4 + kk) * 64 + lane)) * 8;
    const bf16x8 br = *(const bf16x8*)(p.WrF + fo);
    const bf16x8 bi = *(const bf16x8*)(p.WiF + fo);
    accR = mfma32(a, br, accR);
    accI = mfma32(a, bi, accI);
  }
  const int j = nt * 32 + (lane & 31);
  const int hc = h * 64 + j;
  float xv[16];
#pragma unroll
  for (int r = 0; r < 16; ++r) xv[r] = bf2f(sXp[(mt * 32 + crow(r, lane)) * 72 + j]);
  __syncthreads();
  float* sLa = (float*)smem;
  float* sU = (float*)(smem + 32768);
  {
    const float br_ = ld_br, bi_ = ld_bi;
    const float sp = log1pf(expf(-ld_lam));
#pragma unroll
    for (int r = 0; r < 16; ++r) {
      const int tl2 = mt * 32 + crow(r, lane);
      const float rr = sigm(accR[r] + br_);
      const float ii = sigm(accI[r] + bi_);
      const float la = -8.f * rr * sp;
      const float u = sqrtf(-expm1f(2.f * la)) * ii * xv[r];
      sLa[tl2 * 64 + j] = la;
      sU[tl2 * 64 + j] = u;
      asm volatile("" ::: "memory");
    }
  }
  __syncthreads();
  const int seg = tid >> 6, ch = tid & 63;
  float* sSegA = (float*)(smem + 65536);
  float* sSegH = sSegA + 512;
  {
    float cum = 0.f, hh = 0.f;
#pragma unroll 4
    for (int i = 0; i < 16; ++i) {
      const int ix = (seg * 16 + i) * 64 + ch;
      const float la = sLa[ix], u = sU[ix];
      hh = __expf(la) * hh + u;
      cum += la;
      sU[ix] = hh; sLa[ix] = cum;
    }
    sSegA[seg * 64 + ch] = cum; sSegH[seg * 64 + ch] = hh;
  }
  __syncthreads();
  {
    float cH = 0.f, cL = 0.f;
#pragma unroll
    for (int s2 = 0; s2 < 7; ++s2) {
      if (s2 < seg) {
        const float A = sSegA[s2 * 64 + ch];
        cH = __expf(A) * cH + sSegH[s2 * 64 + ch];
        cL += A;
      }
    }
#pragma unroll 2
    for (int i = 0; i < 16; ++i) {
      const int ix = (seg * 16 + i) * 64 + ch;
      const float cs = sLa[ix];
      const float lp = cs + cL;
      const float hl = sU[ix] + __expf(cs) * cH;
      const size_t go = (size_t)(t0 + seg * 16 + i) * 512 + h * 64 + ch;
      p.hloc[go] = f2bf(hl);
      p.logP[go] = f2bf(lp);
      if (seg == 7 && i == 15) {
        p.Hend[tile * 512 + h * 64 + ch] = hl;
        p.Pend[tile * 512 + h * 64 + ch] = lp;
      }
    }
  }
  __syncthreads();
}

DEV void p4_mixer2(const Params& p, int item, char* smem) {
  const int tid = tidx();
  const int tile = item >> 3, h = item & 7;
  const int t0 = tile * 128;
  const int b = tile >> 6, cidx = tile & 63;
  float* sSegA = (float*)smem;
  float* sSegH = sSegA + 512;
  float* sCarry = sSegH + 512;
  const int seg = tid >> 6, ch = tid & 63;
  const int tl = tid >> 2, q4 = tid & 3;
  const size_t t = (size_t)t0 + tl;
  const int cb = h * 64 + q4 * 16;
  const uint4 ld_h0 = *(const uint4*)(p.hloc + t * 512 + cb), ld_h1 = *(const uint4*)(p.hloc + t * 512 + cb + 8);
  const uint4 ld_p0 = *(const uint4*)(p.logP + t * 512 + cb), ld_p1 = *(const uint4*)(p.logP + t * 512 + cb + 8);
  const uint4 ld_g0 = *(const uint4*)(p.z + t * 2560 + 2048 + cb), ld_g1 = *(const uint4*)(p.z + t * 2560 + 2048 + cb + 8);
  {
    float A = 0.f, H = 0.f;
#pragma unroll
    for (int i = 0; i < 8; ++i) {
      const int c2 = seg * 8 + i;
      if (c2 < cidx) {
        const size_t o = (size_t)(b * 64 + c2) * 512 + h * 64 + ch;
        const float pl = p.Pend[o];
        H = __expf(pl) * H + p.Hend[o];
        A += pl;
      }
    }
    sSegA[seg * 64 + ch] = A; sSegH[seg * 64 + ch] = H;
  }
  __syncthreads();
  if (tid < 64) {
    float cH = 0.f;
#pragma unroll
    for (int s2 = 0; s2 < 8; ++s2) cH = __expf(sSegA[s2 * 64 + ch]) * cH + sSegH[s2 * 64 + ch];
    sCarry[ch] = cH;
  }
  __syncthreads();
  float hl[16], lp[16], gr[16], yb[16];
  unpack8(ld_h0, hl); unpack8(ld_h1, hl + 8);
  unpack8(ld_p0, lp); unpack8(ld_p1, lp + 8);
  unpack8(ld_g0, gr); unpack8(ld_g1, gr + 8);
  float ss = 0.f;
#pragma unroll
  for (int c = 0; c < 16; ++c) {
    const float hv = hl[c] + __expf(lp[c]) * sCarry[q4 * 16 + c];
    yb[c] = hv * gelu_tanh(gr[c]);
    ss += yb[c] * yb[c];
  }
  ss += __shfl_xor(ss, 1, 64);
  ss += __shfl_xor(ss, 2, 64);
  const float rstd = rsqrtf(ss * (1.f / 64.f) + 1e-6f);
  unsigned o[8];
#pragma unroll
  for (int c2 = 0; c2 < 8; ++c2)
    o[c2] = pack2(yb[c2 * 2] * rstd * p.gn_b[cb + c2 * 2], yb[c2 * 2 + 1] * rstd * p.gn_b[cb + c2 * 2 + 1]);
  *(uint4*)(p.ycat + t * 1024 + 512 + cb) = make_uint4(o[0], o[1], o[2], o[3]);
  *(uint4*)(p.ycat + t * 1024 + 512 + cb + 8) = make_uint4(o[4], o[5], o[6], o[7]);
  __syncthreads();
}

__constant__ unsigned FTAB[16] = {0x03020100u, 0x07060504u, 0x0B0A0908u, 0x0F0E0D0Cu, 0x13121110u, 0x17161514u, 0x23222120u, 0x33323130u,
                                  0x24424140u, 0x61605150u, 0x90807170u, 0xD0C0B0A0u, 0xFFFFF0E0u, 0xFFFFFFFFu, 0xFFFFFFFFu, 0xFFFFFFFFu};
DEV void p7_route(const Params& p, int item, char* smem) {
  const int tid = tidx(), lane = tid & 63, w = tid >> 6;
  const int mt = item >> 3, hh = item & 7;
  const int m0 = mt * 128;
  const int rg = lane >> 4, li = lane & 15;
  bf16x8 bkf[4];
#pragma unroll
  for (int kk = 0; kk < 4; ++kk)
    bkf[kk] = *(const bf16x8*)(p.keysF + (size_t)(((((hh * 2 + (w >> 2)) * 4 + (w & 3)) * 4 + kk) * 64 + lane)) * 8);
  const unsigned tabw = FTAB[li];
  f32x16 acc0 = zero16(), acc1 = zero16();
  gemm_core(p.h, p.WqT, m0, hh * 128, smem, acc0, acc1);
  u16* sQ = (u16*)smem;
  float* sS = (float*)(smem + 34816);
  unsigned* sTop = (unsigned*)(smem + 34816 + 34816);
  {
    const int wr = w >> 1, wc = w & 1;
#pragma unroll
    for (int r = 0; r < 16; ++r) {
      const int row = wr * 32 + crow(r, lane);
      sQ[row * 136 + wc * 64 + (lane & 31)] = f2bf(acc0[r]);
      sQ[row * 136 + wc * 64 + 32 + (lane & 31)] = f2bf(acc1[r]);
    }
  }
  __syncthreads();
#pragma unroll 1
  for (int chunk = 0; chunk < 4; ++chunk) {
    {
      const int c = w >> 2, nt = w & 3;
      f32x16 s = zero16();
#pragma unroll
      for (int kk = 0; kk < 4; ++kk) {
        const bf16x8 a = *(const bf16x8*)(smem + (chunk * 32 + (lane & 31)) * 272 +
                                          (c * 64 + kk * 16 + (lane >> 5) * 8) * 2);
        s = mfma32(a, bkf[kk], s);
      }
#pragma unroll
      for (int r = 0; r < 16; ++r) sS[(c * 32 + crow(r, lane)) * 136 + nt * 32 + (lane & 31)] = s[r];
    }
    __syncthreads();
    const int tokl = w * 4 + rg;
    unsigned res[2];
#pragma unroll
    for (int c = 0; c < 2; ++c) {
      unsigned k[8];
#pragma unroll
      for (int jj = 0; jj < 8; ++jj) {
        const float v = sS[(c * 32 + tokl) * 136 + li + 16 * jj];
        k[jj] = (sortable(v) & ~127u) | (unsigned)(li + 16 * jj);
      }
#define CE_(i, j) { const unsigned hi_ = max(k[i], k[j]), lo_ = min(k[i], k[j]); k[i] = hi_; k[j] = lo_; }
      CE_(0, 1) CE_(2, 3) CE_(4, 5) CE_(6, 7) CE_(0, 2) CE_(1, 3) CE_(4, 6) CE_(5, 7) CE_(1, 2) CE_(5, 6)
      CE_(0, 4) CE_(1, 5) CE_(2, 6) CE_(3, 7) CE_(2, 4) CE_(3, 5) CE_(1, 2) CE_(3, 4) CE_(5, 6)
#undef CE_
      unsigned r_ = 0;
#pragma unroll
      for (int it = 0; it < 16; ++it) {
        const unsigned m = row_max_u(k[0]);
        const bool win = (k[0] == m);
        r_ = (li == it) ? m : r_;
#pragma unroll
        for (int jj = 0; jj < 7; ++jj) k[jj] = win ? k[jj + 1] : k[jj];
        k[7] = win ? 0u : k[7];
      }
      res[c] = r_;
    }
    unsigned* tp = sTop + (w * 4 + rg) * 32;
    tp[li] = res[0];
    tp[16 + li] = res[1];
    __syncthreads();
    {
      unsigned ck[4];
#pragma unroll
      for (int j = 0; j < 4; ++j) {
        const unsigned code = (tabw >> (8 * j)) & 0xFFu;
        const float s0 = unsortable(tp[code >> 4] & ~127u);
        const float s1 = unsortable(tp[16 + (code & 15u)] & ~127u);
        const unsigned key = (sortable(s0 + s1) & ~255u) | code;
        ck[j] = (code == 0xFFu) ? 0u : key;
      }
#define CE4_(i, j) { const unsigned hi_ = max(ck[i], ck[j]), lo_ = min(ck[i], ck[j]); ck[i] = hi_; ck[j] = lo_; }
      CE4_(0, 1) CE4_(2, 3) CE4_(0, 2) CE4_(1, 3) CE4_(1, 2)
#undef CE4_
      unsigned r_ = 0;
#pragma unroll
      for (int it = 0; it < 16; ++it) {
        const unsigned m = row_max_u(ck[0]);
        const bool win = (ck[0] == m);
        r_ = (li == it) ? m : r_;
        ck[0] = win ? ck[1] : ck[0];
        ck[1] = win ? ck[2] : ck[1];
        ck[2] = win ? ck[3] : ck[2];
        ck[3] = win ? 0u : ck[3];
      }
      const int pos = r_ & 255;
      const int i0 = tp[pos >> 4] & 127, i1 = tp[16 + (pos & 15)] & 127;
      const float bs = unsortable(r_ & ~255u);
      const float mx = unsortable(row_max_u(r_) & ~255u);
      const float e = __expf(bs - mx);
      const float sum = row_sum_f(e);
      const size_t tg = (size_t)m0 + chunk * 32 + tokl;
      p.idx16[tg * 128 + hh * 16 + li] = (unsigned short)(i0 * 128 + i1);
      p.gsel[tg * 128 + hh * 16 + li] = e / sum;
    }
    __syncthreads();
  }
}

DEV void unpack_fp8x16(uint4 v, float* f) {
  typedef float f2_t __attribute__((ext_vector_type(2)));
  f2_t r;
  r = __builtin_amdgcn_cvt_pk_f32_fp8((int)v.x, false); f[0] = r.x; f[1] = r.y;
  r = __builtin_amdgcn_cvt_pk_f32_fp8((int)v.x, true);  f[2] = r.x; f[3] = r.y;
  r = __builtin_amdgcn_cvt_pk_f32_fp8((int)v.y, false); f[4] = r.x; f[5] = r.y;
  r = __builtin_amdgcn_cvt_pk_f32_fp8((int)v.y, true);  f[6] = r.x; f[7] = r.y;
  r = __builtin_amdgcn_cvt_pk_f32_fp8((int)v.z, false); f[8] = r.x; f[9] = r.y;
  r = __builtin_amdgcn_cvt_pk_f32_fp8((int)v.z, true);  f[10] = r.x; f[11] = r.y;
  r = __builtin_amdgcn_cvt_pk_f32_fp8((int)v.w, false); f[12] = r.x; f[13] = r.y;
  r = __builtin_amdgcn_cvt_pk_f32_fp8((int)v.w, true);  f[14] = r.x; f[15] = r.y;
}
typedef _Float16 h2_t __attribute__((ext_vector_type(2)));
DEV unsigned packh2(float a, float b) {
  h2_t v; v.x = (_Float16)a; v.y = (_Float16)b;
  return __builtin_bit_cast(unsigned, v);
}
DEV float sum8_f(float v) {
  v += __uint_as_float(dpp_u<0xB1>(__float_as_uint(v)));
  v += __uint_as_float(dpp_u<0x4E>(__float_as_uint(v)));
  v += __uint_as_float(dpp_u<0x141>(__float_as_uint(v)));
  return v;
}
DEV unsigned id_of(const unsigned* w, int i) { return (i & 1) ? (w[i >> 1] >> 16) : (w[i >> 1] & 0xFFFFu); }
DEV float half_of(const unsigned* w, int i) {
  const unsigned short b = (i & 1) ? (unsigned short)(w[i >> 1] >> 16) : (unsigned short)(w[i >> 1] & 0xFFFFu);
  return (float)__builtin_bit_cast(_Float16, b);
}
DEV void p8_udots_all(const Params& p) {
  const int tid = tidx(), lane = tid & 63, w = tid >> 6;
  const int es = lane >> 3, cl = lane & 7;
  const unsigned lo = cl * 16;
  const int n = 65536;
  int v = blockIdx.x;
  if (v >= n) return;
  unsigned idw[8];
  uint4 hq, rA[8];
  {
    const size_t t = (size_t)(v >> 3) * 8 + w;
    const uint4 i0 = *(const uint4*)(p.idx16 + t * 128 + es * 16);
    const uint4 i1 = *(const uint4*)(p.idx16 + t * 128 + es * 16 + 8);
    hq = *(const uint4*)(p.h8 + t * 1024 + (v & 7) * 128 + cl * 16);
    idw[0] = i0.x; idw[1] = i0.y; idw[2] = i0.z; idw[3] = i0.w; idw[4] = i1.x; idw[5] = i1.y; idw[6] = i1.z; idw[7] = i1.w;
    const unsigned char* ub0 = p.Ub + (size_t)(v & 7) * (16384 * 128);
#pragma unroll
    for (int i = 0; i < 8; ++i) rA[i] = *(const uint4*)(ub0 + (id_of(idw, i) * 128u + lo));
  }
#define U_ROW(RW, OUT)                                                                     \
  {                                                                                        \
    int isum = __builtin_amdgcn_sdot4((int)(RW).x, (int)hcur.x, 0, false);                 \
    isum = __builtin_amdgcn_sdot4((int)(RW).y, (int)hcur.y, isum, false);                  \
    isum = __builtin_amdgcn_sdot4((int)(RW).z, (int)hcur.z, isum, false);                  \
    isum = __builtin_amdgcn_sdot4((int)(RW).w, (int)hcur.w, isum, false);                  \
    unsigned us = (unsigned)isum;                                                          \
    us += dpp_u<0xB1>(us); us += dpp_u<0x4E>(us); us += dpp_u<0x141>(us);                  \
    asm volatile("" : "+v"(us));                                                           \
    OUT = (float)(int)us * (1.f / 256.f);                                                  \
    __builtin_amdgcn_sched_barrier(0);                                                     \
  }
#pragma unroll 1
  for (; v < n; v += gridDim.x) {
    const int x = v & 7;
    const size_t t = (size_t)(v >> 3) * 8 + w;
    const uint4 hcur = hq;
    const unsigned char* ub = p.Ub + (size_t)x * (16384 * 128);
    uint4 rB[8];
#pragma unroll
    for (int i = 0; i < 8; ++i) rB[i] = *(const uint4*)(ub + (id_of(idw, 8 + i) * 128u + lo));
    {
      const int vn = min(v + (int)gridDim.x, n - 8 + x);
      const size_t tn = (size_t)(vn >> 3) * 8 + w;
      const uint4 n0 = *(const uint4*)(p.idx16 + tn * 128 + es * 16);
      const uint4 n1 = *(const uint4*)(p.idx16 + tn * 128 + es * 16 + 8);
      hq = *(const uint4*)(p.h8 + tn * 1024 + x * 128 + cl * 16);
      idw[0] = n0.x; idw[1] = n0.y; idw[2] = n0.z; idw[3] = n0.w; idw[4] = n1.x; idw[5] = n1.y; idw[6] = n1.z; idw[7] = n1.w;
    }
    __builtin_amdgcn_sched_barrier(0);
    unsigned dp[8];
#pragma unroll
    for (int i2 = 0; i2 < 4; ++i2) {
      float d0, d1;
      U_ROW(rA[i2 * 2], d0)
      U_ROW(rA[i2 * 2 + 1], d1)
      dp[i2] = packh2(d0, d1);
    }
#pragma unroll
    for (int i = 0; i < 8; ++i) rA[i] = *(const uint4*)(ub + (id_of(idw, i) * 128u + lo));
    __builtin_amdgcn_sched_barrier(0);
#pragma unroll
    for (int i2 = 0; i2 < 4; ++i2) {
      float d0, d1;
      U_ROW(rB[i2 * 2], d0)
      U_ROW(rB[i2 * 2 + 1], d1)
      dp[4 + i2] = packh2(d0, d1);
    }
    if (cl == 0) {
      unsigned short* pp = p.Pd + (t * 8 + (size_t)x) * 128 + es * 16;
      *(uint4*)pp = make_uint4(dp[0], dp[1], dp[2], dp[3]);
      *(uint4*)(pp + 8) = make_uint4(dp[4], dp[5], dp[6], dp[7]);
    }
  }
#undef U_ROW
}
DEV void p8_coef(const Params& p, int item) {
  const int tid = tidx(), lane = tid & 63, w = tid >> 6;
  const size_t t0 = (size_t)item * 32 + w * 4;
  float s0[4], s1[4];
  unsigned iw[4];
  float2 gv[4];
#pragma unroll
  for (int k = 0; k < 4; ++k) {
    const size_t t = t0 + k;
    s0[k] = 0.f; s1[k] = 0.f;
#pragma unroll
    for (int x = 0; x < 8; ++x) {
      const unsigned pv = *(const unsigned*)(p.Pd + (t * 8 + (size_t)x) * 128 + lane * 2);
      s0[k] += half_of(&pv, 0); s1[k] += half_of(&pv, 1);
    }
    iw[k] = *(const unsigned*)(p.idx16 + t * 128 + lane * 2);
    gv[k] = *(const float2*)(p.gsel + t * 128 + lane * 2);
  }
#pragma unroll
  for (int k = 0; k < 4; ++k) {
    const size_t t = t0 + k;
    const unsigned ia = iw[k] & 0xFFFFu, ib = iw[k] >> 16;
    const float hs = 256.f * p.hS[t];
    const float d0 = s0[k] * p.uS[ia] * hs, d1 = s1[k] * p.uS[ib] * hs;
    const float a0 = 0.5f * d0 * (1.f + erff(d0 * 0.7071067811865476f));
    const float a1 = 0.5f * d1 * (1.f + erff(d1 * 0.7071067811865476f));
    *(unsigned*)(p.coef16 + t * 128 + lane * 2) = packh2(1024.f * gv[k].x * a0 * p.vS[ia], 1024.f * gv[k].y * a1 * p.vS[ib]);
  }
}
DEV void p8_vacc_all(const Params& p, char* smem) {
  const int tid = tidx(), lane = tid & 63, w = tid >> 6;
  const int es = lane >> 3, cl = lane & 7;
  const unsigned lo = cl * 16;
  const int n = 65536;
  int v = blockIdx.x;
  if (v >= n) return;
  unsigned idw[8];
  uint4 rA[8];
  {
    const size_t t = (size_t)(v >> 3) * 8 + w;
    const uint4 i0 = *(const uint4*)(p.idx16 + t * 128 + es * 16);
    const uint4 i1 = *(const uint4*)(p.idx16 + t * 128 + es * 16 + 8);
    idw[0] = i0.x; idw[1] = i0.y; idw[2] = i0.z; idw[3] = i0.w; idw[4] = i1.x; idw[5] = i1.y; idw[6] = i1.z; idw[7] = i1.w;
    const unsigned char* vb0 = p.Vb + (size_t)(v & 7) * (16384 * 128);
#pragma unroll
    for (int i = 0; i < 8; ++i) rA[i] = *(const uint4*)(vb0 + (id_of(idw, i) * 128u + lo));
  }
#define V_CONSUME(RW, I)                                                                                   \
  {                                                                                                        \
    const h2_t cpair = __builtin_bit_cast(h2_t, cw[(I) >> 1]);                                             \
    h2_t cf2;                                                                                              \
    cf2.x = ((I) & 1) ? cpair.y : cpair.x; cf2.y = cf2.x;                                                  \
    const unsigned wds[4] = {(RW).x, (RW).y, (RW).z, (RW).w};                                              \
    _Pragma("unroll") for (int d4 = 0; d4 < 4; ++d4) {                                                     \
      const h2_t v0 = __builtin_amdgcn_cvt_scalef32_pk_f16_fp8(wds[d4], 1.0f, false);                      \
      const h2_t v1 = __builtin_amdgcn_cvt_scalef32_pk_f16_fp8(wds[d4], 1.0f, true);                       \
      acc2[d4 * 2] = cf2 * v0 + acc2[d4 * 2];                                                              \
      acc2[d4 * 2 + 1] = cf2 * v1 + acc2[d4 * 2 + 1];                                                      \
    }                                                                                                      \
    asm volatile("" : "+v"(acc2[0]), "+v"(acc2[1]), "+v"(acc2[2]), "+v"(acc2[3]), "+v"(acc2[4]), "+v"(acc2[5]), "+v"(acc2[6]), "+v"(acc2[7])); \
    __builtin_amdgcn_sched_barrier(0);                                                                     \
  }
#pragma unroll 1
  for (; v < n; v += gridDim.x) {
    const int x = v & 7;
    const size_t t = (size_t)(v >> 3) * 8 + w;
    const uint4 c0 = *(const uint4*)(p.coef16 + t * 128 + es * 16);
    const uint4 c1 = *(const uint4*)(p.coef16 + t * 128 + es * 16 + 8);
    const unsigned cw[8] = {c0.x, c0.y, c0.z, c0.w, c1.x, c1.y, c1.z, c1.w};
    const unsigned char* vb = p.Vb + (size_t)x * (16384 * 128);
    uint4 rB[8];
#pragma unroll
    for (int i = 0; i < 8; ++i) rB[i] = *(const uint4*)(vb + (id_of(idw, 8 + i) * 128u + lo));
    const int vn = min(v + (int)gridDim.x, n - 8 + x);
    const size_t tn = (size_t)(vn >> 3) * 8 + w;
    {
      const uint4 n0 = *(const uint4*)(p.idx16 + tn * 128 + es * 16);
      const uint4 n1 = *(const uint4*)(p.idx16 + tn * 128 + es * 16 + 8);
      idw[0] = n0.x; idw[1] = n0.y; idw[2] = n0.z; idw[3] = n0.w; idw[4] = n1.x; idw[5] = n1.y; idw[6] = n1.z; idw[7] = n1.w;
    }
    __builtin_amdgcn_sched_barrier(0);
    h2_t acc2[8];
#pragma unroll
    for (int j = 0; j < 8; ++j) { acc2[j].x = (_Float16)0.f; acc2[j].y = (_Float16)0.f; }
    const int b = (int)(t >> 13);
    const int col = x * 128 + lane * 2;
#pragma unroll
    for (int i = 0; i < 8; ++i) V_CONSUME(rA[i], i)
#pragma unroll
    for (int i = 0; i < 8; ++i) rA[i] = *(const uint4*)(vb + (id_of(idw, i) * 128u + lo));
    __builtin_amdgcn_sched_barrier(0);
#pragma unroll
    for (int i = 0; i < 8; ++i) V_CONSUME(rB[i], 8 + i)
    const float2 gv = *(const float2*)(p.ada + b * 6144 + 5120 + col);
    const unsigned xw = *(const unsigned*)(p.x1b + t * 1024 + col);
    unsigned* sWh = (unsigned*)smem + w * (8 * 68);
    *(uint4*)(sWh + es * 68 + cl * 8) = make_uint4(__builtin_bit_cast(unsigned, acc2[0]), __builtin_bit_cast(unsigned, acc2[1]),
                                                   __builtin_bit_cast(unsigned, acc2[2]), __builtin_bit_cast(unsigned, acc2[3]));
    *(uint4*)(sWh + es * 68 + cl * 8 + 4) = make_uint4(__builtin_bit_cast(unsigned, acc2[4]), __builtin_bit_cast(unsigned, acc2[5]),
                                                       __builtin_bit_cast(unsigned, acc2[6]), __builtin_bit_cast(unsigned, acc2[7]));
    __builtin_amdgcn_fence(__ATOMIC_RELEASE, "wavefront");
    __builtin_amdgcn_wave_barrier();
    __builtin_amdgcn_fence(__ATOMIC_ACQUIRE, "wavefront");
    h2_t hsum = __builtin_bit_cast(h2_t, sWh[lane]);
#pragma unroll
    for (int e2 = 1; e2 < 8; ++e2) hsum = hsum + __builtin_bit_cast(h2_t, sWh[e2 * 68 + lane]);
    const float o0 = (float)hsum.x, o1 = (float)hsum.y;
    __builtin_amdgcn_fence(__ATOMIC_RELEASE, "wavefront");
    __builtin_amdgcn_wave_barrier();
    const float2 xv = make_float2(__uint_as_float(xw << 16), __uint_as_float(xw & 0xFFFF0000u));
    float2 o;
    o.x = xv.x + gv.x * (o0 * (1.f / 1024.f)); o.y = xv.y + gv.y * (o1 * (1.f / 1024.f));
    *(unsigned*)(p.x2b + t * 1024 + col) = pack2(o.x, o.y);
  }
#undef V_CONSUME
}
DEV void p8_final(const Params& p, int item) {
  const int tid = tidx(), lane = tid & 63, w = tid >> 6;
  const size_t t0 = (size_t)item * 32 + w * 4;
  float4 fg[4];
#pragma unroll
  for (int i = 0; i < 4; ++i) fg[i] = *(const float4*)(p.final_g + i * 256 + lane * 4);
  uint2 r2[4][4];
#pragma unroll
  for (int k = 0; k < 4; ++k)
#pragma unroll
    for (int i = 0; i < 4; ++i) r2[k][i] = *(const uint2*)(p.x2b + (t0 + k) * 1024 + i * 256 + lane * 4);
#pragma unroll
  for (int k = 0; k < 4; ++k) {
    const size_t t = t0 + k;
    float xv[16];
    float ss = 0.f;
#pragma unroll
    for (int i = 0; i < 4; ++i) {
      xv[i * 4 + 0] = __uint_as_float(r2[k][i].x << 16); xv[i * 4 + 1] = __uint_as_float(r2[k][i].x & 0xFFFF0000u);
      xv[i * 4 + 2] = __uint_as_float(r2[k][i].y << 16); xv[i * 4 + 3] = __uint_as_float(r2[k][i].y & 0xFFFF0000u);
      ss += xv[i * 4] * xv[i * 4] + xv[i * 4 + 1] * xv[i * 4 + 1] + xv[i * 4 + 2] * xv[i * 4 + 2] + xv[i * 4 + 3] * xv[i * 4 + 3];
    }
    ss = wave_allsum(ss);
    const float r = rsqrtf(ss * (1.f / 1024.f) + 1e-6f);
#pragma unroll
    for (int i = 0; i < 4; ++i)
      *(float4*)(p.out + t * 1024 + i * 256 + lane * 4) =
          make_float4(xv[i * 4] * r * fg[i].x, xv[i * 4 + 1] * r * fg[i].y, xv[i * 4 + 2] * r * fg[i].z, xv[i * 4 + 3] * r * fg[i].w);
  }
}

#define XB_TMO      128
#define XB_XCNT(j)  (256  + 64 * (j))
#define XB_XSUB(j)  (1280 + 64 * (j))
#define XB_XGEN(j)  (2304 + 64 * (j))
#define XB_TOP      3328
#define XB_TOPGEN   3392
#define XCD_BAR_WORDS 3456
#define XB_SPIN_CAP (1u << 22)
#define LAS __attribute__((address_space(3)))
DEV unsigned xb_ld(unsigned* p)              { return __hip_atomic_load(p, __ATOMIC_RELAXED, __HIP_MEMORY_SCOPE_AGENT); }
DEV unsigned xb_add(unsigned* p, unsigned v) { return __hip_atomic_fetch_add(p, v, __ATOMIC_RELAXED, __HIP_MEMORY_SCOPE_AGENT); }
DEV unsigned xb_xcc_id() { return (unsigned)__builtin_amdgcn_s_getreg((3 << 11) | 20) & 0xFu; }
#define XB_SPIN(cond, bar) do { unsigned _sp = 0; while (cond) { __builtin_amdgcn_s_sleep(1); \
    if ((++_sp & 255u) == 0u) { if (xb_ld(&(bar)[XB_TMO])) break; if (_sp > XB_SPIN_CAP) { atomicAdd(&(bar)[XB_TMO], 1u); break; } } } } while (0)
struct XcdBarrier { unsigned* bar; unsigned x; volatile LAS unsigned* st; };
DEV XcdBarrier xcd_barrier_post(unsigned* bar, volatile LAS unsigned* st) {
  XcdBarrier b; b.bar = bar; b.x = xb_xcc_id(); b.st = st;
  if (threadIdx.x == 0) (void)xb_add(&bar[XB_XCNT(b.x)], 1u);
  return b;
}
DEV void xcd_barrier_complete(unsigned* bar, unsigned x, unsigned& nloc, unsigned& nx) {
  const unsigned G = gridDim.x * gridDim.y * gridDim.z;
  unsigned sum, cnt, mine, sp = 0u;
  for (;;) {
    sum = 0u; cnt = 0u; mine = 0u;
#pragma unroll
    for (unsigned j = 0; j < 16; ++j) { const unsigned c = xb_ld(&bar[XB_XCNT(j)]); sum += c; cnt += (c > 0u) ? 1u : 0u; mine = (j == x) ? c : mine; }
    if (sum == G) break;
    __builtin_amdgcn_s_sleep(1);
    if ((++sp & 255u) == 0u) { if (xb_ld(&bar[XB_TMO])) break; if (sp > XB_SPIN_CAP) { atomicAdd(&bar[XB_TMO], 1u); break; } }
  }
  nloc = mine > 0u ? mine : 1u; nx = cnt > 0u ? cnt : 1u;
}
DEV void xcd_barrier(const XcdBarrier& b) {
  asm volatile("s_waitcnt vmcnt(0)" ::: "memory");
  __syncthreads();
  if (threadIdx.x == 0) {
    unsigned* bar = b.bar;
    __builtin_amdgcn_s_waitcnt(0);
    unsigned nloc = b.st[0], nx = b.st[1];
    if (nloc == 0u) { xcd_barrier_complete(bar, b.x, nloc, nx); b.st[0] = nloc; b.st[1] = nx; }
    const unsigned old = xb_add(&bar[XB_XSUB(b.x)], 1u);
    const unsigned gen = old / nloc;
    if (old + 1u == (gen + 1u) * nloc) {
      __builtin_amdgcn_fence(__ATOMIC_RELEASE, "agent");
      asm volatile("s_waitcnt vmcnt(0)" ::: "memory");
      const unsigned og = xb_add(&bar[XB_TOP], 1u);
      const unsigned tg = og / nx;
      if (og + 1u == (tg + 1u) * nx) xb_add(&bar[XB_TOPGEN], 1u);
      else XB_SPIN(xb_ld(&bar[XB_TOPGEN]) == tg, bar);
      __builtin_amdgcn_fence(__ATOMIC_ACQUIRE, "agent");
      xb_add(&bar[XB_XGEN(b.x)], 1u);
      asm volatile("s_waitcnt vmcnt(0)" ::: "memory");
    } else {
      XB_SPIN(xb_ld(&bar[XB_XGEN(b.x)]) == gen, bar);
      __builtin_amdgcn_fence(__ATOMIC_ACQUIRE, "agent");
      asm volatile("s_waitcnt vmcnt(0)" ::: "memory");
    }
  }
  __syncthreads();
}

DEV int xcd_swz(int v, int n) { return (v & 7) * (n >> 3) + (v >> 3); }

template <int PH> DEV void run_phase(const Params& p, char* smem) {
  if (PH == 3) {
    int hcur = -1;
#pragma unroll 1
    for (int v = blockIdx.x; v < 4096; v += gridDim.x) {
      const int h = v & 7;
      if (h != hcur) { p3_stage_head(p, h, smem); hcur = h; }
      p3_mixer1(p, v, smem);
    }
    return;
  }
  if (PH == 2 || PH == 5 || PH == 7) {
    if (blockIdx.x >= (gridDim.x >> 1)) {
#pragma unroll 1
      for (int i_ = 0; i_ < 6; ++i_) __builtin_amdgcn_s_sleep(100);
    }
  }
  if (PH == 8) { p8_udots_all(p); return; }
  if (PH == 10) { p8_vacc_all(p, smem); return; }
  constexpr int n = PH == 0 ? P0_ITEMS : PH == 1 ? 1024 : PH == 2 ? 5120 : PH == 3 ? 4096 : PH == 4 ? 4096
                  : PH == 5 ? 2048 : PH == 6 ? 1024 : PH == 7 ? 4096 : PH == 8 ? 65536 : PH == 9 ? 2048
                  : PH == 10 ? 65536 : 2048;
  for (int v = blockIdx.x; v < n; v += gridDim.x) {
    if (PH == 0) phase0(p, v, smem);
    else if (PH == 1) p_norm_mod<false>(p.x, p.norm1_g, p.ada, 0, 1024, p.h, nullptr, nullptr, v);
    else if (PH == 2) p2_gemm1(p, xcd_swz(v, n), smem);
    else if (PH == 3) p3_mixer1(p, v, smem);
    else if (PH == 4) p4_mixer2(p, v, smem);
    else if (PH == 5) p5_gemm2(p, xcd_swz(v, n), smem);
    else if (PH == 6) p_norm_mod<true>(p.x1b, p.norm2_g, p.ada, 3072, 4096, p.h, p.h8, p.hS, v);
    else if (PH == 7) p7_route(p, xcd_swz(v, n), smem);
    else if (PH == 9) p8_coef(p, v);
    else p8_final(p, v);
  }
}

#if MULTI_LAUNCH
template <int PH> __global__ void __launch_bounds__(NT) k_phase(Params p) {
  extern __shared__ __attribute__((aligned(16))) char smem[];
  run_phase<PH>(p, smem);
}
#else
__global__ void __launch_bounds__(NT, 4) mega(Params p) {
  extern __shared__ __attribute__((aligned(16))) char smem[];
  cg::grid_group grid = cg::this_grid();
  volatile LAS unsigned* xst = (volatile LAS unsigned*)(smem + LDS_PHASE);
  if (threadIdx.x < 2) xst[threadIdx.x] = 0u;
  __syncthreads();
  const XcdBarrier xb = xcd_barrier_post(p.bar, xst);
  if (p.reps < 0) grid.sync();
#ifndef PROBE_PH
#define PROBE_PH -1
#endif
#define RUNPH(K, SYNC)                                                        \
  for (int r_ = 0; r_ < ((PROBE_PH == K) ? p.reps : 1); ++r_) {              \
    run_phase<K>(p, smem);                                                    \
    if (SYNC || PROBE_PH == K) xcd_barrier(xb);                               \
  }
  RUNPH(0, 1) RUNPH(1, 1) RUNPH(2, 1) RUNPH(3, 1) RUNPH(4, 1) RUNPH(5, 1) RUNPH(6, 1) RUNPH(7, 1) RUNPH(8, 1) RUNPH(9, 1) RUNPH(10, 1) RUNPH(11, 0)
}
#endif

extern "C" void kernel_launch(void* const* d_in, const int* in_sizes, int n_in, void* d_out, int out_size,
                              void* d_ws, size_t ws_size, hipStream_t stream) {
  Params p{};
  const float* const* in = (const float* const*)d_in;
  p.x = in[0]; p.c = in[1]; p.w_ada = in[2]; p.b_ada = in[3]; p.norm1_g = in[4]; p.w_in = in[5];
  p.conv_a_w = in[6]; p.conv_b_w = in[7]; p.conv_b_b = in[8]; p.w_r = in[9]; p.b_r = in[10];
  p.w_i = in[11]; p.b_i = in[12]; p.lam = in[13]; p.gn_a = in[14]; p.gn_b = in[15]; p.w_out = in[16];
  p.norm2_g = in[17]; p.w_q = in[18]; p.sub_keys = in[19]; p.expert_u = in[20]; p.expert_v = in[21];
  p.final_g = in[22];
  p.out = (float*)d_out;
  char* ws = (char*)d_ws;
  size_t off = 0;
  auto alloc = [&](size_t bytes) { void* r = ws + off; off += (bytes + 255) & ~(size_t)255; return r; };
  p.ada = (float*)alloc(8 * 6144 * 4);
  p.WinT = (u16*)alloc((size_t)2560 * 1024 * 2);
  p.WoutT = (u16*)alloc((size_t)1024 * 1024 * 2);
  p.WqT = (u16*)alloc((size_t)1024 * 1024 * 2);
  p.keysF = (u16*)alloc(131072 * 2);
  p.WrF = (u16*)alloc(32768 * 2);
  p.WiF = (u16*)alloc(32768 * 2);
  p.Ub = (unsigned char*)alloc((size_t)16384 * 1024);
  p.Vb = (unsigned char*)alloc((size_t)16384 * 1024);
  p.uS = (float*)alloc(16384 * 4);
  p.vS = (float*)alloc(16384 * 4);
  p.h = (u16*)alloc((size_t)T_ * 1024 * 2);
  p.z = (u16*)alloc((size_t)T_ * 2560 * 2);
  p.ycat = (u16*)alloc((size_t)T_ * 1024 * 2);
  p.hloc = (u16*)alloc((size_t)T_ * 512 * 2);
  p.logP = (u16*)alloc((size_t)T_ * 512 * 2);
  p.Hend = (float*)alloc(512 * 512 * 4);
  p.Pend = (float*)alloc(512 * 512 * 4);
  p.x1b = p.z;
  p.x2b = p.h;
  p.gsel = (float*)p.logP;
  p.Pd = p.ycat;
  p.coef16 = p.logP + (size_t)T_ * 128 * 2;
  p.idx16 = p.hloc;
  p.ssq = (float*)alloc((size_t)8 * T_ * 4);
  p.h8 = (signed char*)alloc((size_t)T_ * 1024);
  p.hS = (float*)alloc((size_t)T_ * 4);
  p.bar = (unsigned*)alloc(XCD_BAR_WORDS * 4);
  p.reps = 2; p.pad_ = 0;
#if MULTI_LAUNCH
  const int grid = 1024;
#define LAUNCH_PH(PH)                                                                              \
  hipFuncSetAttribute((const void*)k_phase<PH>, hipFuncAttributeMaxDynamicSharedMemorySize, LDS_BYTES); \
  k_phase<PH><<<grid, NT, LDS_BYTES, stream>>>(p);
  LAUNCH_PH(0) LAUNCH_PH(1) LAUNCH_PH(2) LAUNCH_PH(3) LAUNCH_PH(4)
  LAUNCH_PH(5) LAUNCH_PH(6) LAUNCH_PH(7) LAUNCH_PH(8) LAUNCH_PH(9) LAUNCH_PH(10) LAUNCH_PH(11)
#else
  static int grid_blocks = 0;
  hipFuncSetAttribute((const void*)mega, hipFuncAttributeMaxDynamicSharedMemorySize, LDS_BYTES);
  if (!grid_blocks) {
    int dev = 0, cus = 0, per_cu = 0;
    hipGetDevice(&dev);
    hipDeviceGetAttribute(&cus, hipDeviceAttributeMultiprocessorCount, dev);
    hipOccupancyMaxActiveBlocksPerMultiprocessor(&per_cu, mega, NT, LDS_BYTES);
    grid_blocks = cus * per_cu;
  }
  hipMemsetAsync(p.bar, 0, XCD_BAR_WORDS * 4, stream);
  void* args[] = {&p};
  hipError_t e = hipLaunchCooperativeKernel((void*)mega, dim3(grid_blocks), dim3(NT), args, LDS_BYTES, stream);
  if (e != hipSuccess) fprintf(stderr, "cooperative launch failed: %s (grid %d)\n", hipGetErrorString(e), grid_blocks);
#endif
}
```
